# Optimizing an MI355X kernel written in HIP

```python
import jax, jax.numpy as jnp
from jax import lax
import numpy as np


D_MODEL = 1024
BATCH = 2
SEQ = 8192
DEPTH = 1

ATTN_HEADS = 16
HEAD_DIM = 64
ATTN_WIDTH = ATTN_HEADS * HEAD_DIM
DILATED_PATTERNS = ((128, 1), (512, 4), (2048, 16))
SSD_HEADS = 16
SSD_HEAD_DIM = 64
SSD_WIDTH = SSD_HEADS * SSD_HEAD_DIM
SSD_GROUPS = 2
SSD_HEADS_PER_GROUP = SSD_HEADS // SSD_GROUPS
SSD_STATE = 128
SSD_CHUNK = 128
CONV_WIDTH = 5
XBC_WIDTH = SSD_WIDTH + 2 * SSD_GROUPS * SSD_STATE
MIX_WIDTH = ATTN_WIDTH + SSD_WIDTH
IN_PROJ_WIDTH = 3 * ATTN_WIDTH + SSD_WIDTH + XBC_WIDTH + 2 * SSD_HEADS
N_EXPERTS = 32
TOP_K = 4
EXPERT_FF = 1024
SWIGLU_ALPHA = 1.702
SWIGLU_LIMIT = 7.0
RMS_EPS = 1e-6
N_MOD = 6

kernel_name = 'hybrid_dilated_attn_ssd_moe_block'


def _rmsnorm(t, g):
    var = jnp.mean(t * t, axis=-1, keepdims=True)
    return t * lax.rsqrt(var + RMS_EPS) * g


def _alibi_slopes(n):
    return jnp.exp2(-8.0 * jnp.arange(1, n + 1, dtype=jnp.float32) / n)


def _dilated_window_attention(q, k, v, slopes, window, dilation):
    bsz, nh, seq, hd = q.shape
    half = window // (2 * dilation)
    blk = half
    sub_len = seq // dilation
    nb = -(-sub_len // blk)
    pad_len = nb * blk

    def to_sub(t):
        t = t.reshape(bsz, nh, sub_len, dilation, hd).transpose(0, 1, 3, 2, 4)
        return jnp.pad(t, ((0, 0), (0, 0), (0, 0), (0, pad_len - sub_len), (0, 0)))

    qs, ks, vs = to_sub(q), to_sub(k), to_sub(v)
    qb = qs.reshape(bsz, nh, dilation, nb, blk, hd)

    def band(t):
        tp = jnp.pad(t, ((0, 0), (0, 0), (0, 0), (blk, blk), (0, 0)))
        tp = tp.reshape(bsz, nh, dilation, nb + 2, blk, hd)
        return jnp.concatenate([tp[:, :, :, 0:nb], tp[:, :, :, 1:nb + 1], tp[:, :, :, 2:nb + 2]], axis=4)

    kb, vb = band(ks), band(vs)
    scores = jnp.einsum('bhrnqe,bhrnke->bhrnqk', qb, kb)
    q_idx = jnp.arange(nb)[:, None] * blk + jnp.arange(blk)[None, :]
    k_idx = jnp.arange(nb)[:, None] * blk - blk + jnp.arange(3 * blk)[None, :]
    rel = k_idx[:, None, :] - q_idx[:, :, None]
    valid = (jnp.abs(rel) <= half) & (k_idx >= 0)[:, None, :] & (k_idx < sub_len)[:, None, :]
    dist = (jnp.abs(rel) * dilation).astype(jnp.float32)
    scores = scores - slopes[None, :, None, None, None, None] * dist
    scores = jnp.where(valid, scores, -jnp.inf)
    m = jnp.max(scores, axis=-1, keepdims=True)
    p = jnp.exp(scores - m)
    den = jnp.sum(p, axis=-1, keepdims=True)
    o = jnp.einsum('bhrnqk,bhrnke->bhrnqe', p, vb) / den
    lse = (m + jnp.log(den))[..., 0]

    def from_sub(t):
        t = t.reshape(bsz, nh, dilation, pad_len, *t.shape[5:])[:, :, :, :sub_len]
        t = jnp.swapaxes(t, 2, 3)
        return t.reshape(bsz, nh, seq, *t.shape[4:])

    return from_sub(o), from_sub(lse)


def _dilated_mixture_attention(q, k, v):
    slopes = _alibi_slopes(ATTN_HEADS)
    outs, lses = [], []
    for window, dilation in DILATED_PATTERNS:
        o, l = _dilated_window_attention(q, k, v, slopes, window, dilation)
        outs.append(o)
        lses.append(l)
    w = jax.nn.softmax(jnp.stack(lses), axis=0)
    return jnp.einsum('gbhs,gbhse->bhse', w, jnp.stack(outs))


def _ssd_chunked(xs, dt, a, bm, cm):
    bsz, seq = xs.shape[0], xs.shape[1]
    qn = SSD_CHUNK
    nc = seq // qn
    g, e, pdim, n = SSD_GROUPS, SSD_HEADS_PER_GROUP, SSD_HEAD_DIM, SSD_STATE
    xd = (xs * dt[..., None]).reshape(bsz, nc, qn, g, e, pdim)
    a_dt = jnp.moveaxis((dt * a).reshape(bsz, nc, qn, g, e), 2, -1)
    bc = bm.reshape(bsz, nc, qn, g, n)
    cc = cm.reshape(bsz, nc, qn, g, n)
    a_cum = jnp.cumsum(a_dt, axis=-1)
    tril = jnp.tril(jnp.ones((qn, qn), dtype=bool))
    seg = a_cum[..., :, None] - a_cum[..., None, :]
    decay_in = jnp.exp(jnp.where(tril, seg, -jnp.inf))
    cb = jnp.einsum('bclgn,bcsgn->bcgls', cc, bc)
    y_diag = jnp.einsum('bcgels,bcsgep->bclgep', cb[:, :, :, None] * decay_in, xd)
    decay_states = jnp.exp(a_cum[..., -1:] - a_cum)
    xw = xd * jnp.moveaxis(decay_states, -1, 2)[..., None]
    states = jnp.einsum('bcsgn,bcsgep->bcgepn', bc, xw)
    chunk_decay = jnp.exp(a_cum[..., -1])

    def step(h, inp):
        st, dec = inp
        return h * dec[..., None, None] + st, h

    h0 = jnp.zeros((bsz, g, e, pdim, n), dtype=xs.dtype)
    _, h_prev = lax.scan(step, h0, (jnp.moveaxis(states, 1, 0), jnp.moveaxis(chunk_decay, 1, 0)))
    h_prev = jnp.moveaxis(h_prev, 0, 1)
    y_off = jnp.einsum('bclgn,bcgepn->bclgep', cc, h_prev) * jnp.moveaxis(jnp.exp(a_cum), -1, 2)[..., None]
    return (y_diag + y_off).reshape(bsz, seq, g, e, pdim)


def _token_mixer(h, w_in, conv_w, conv_b, dt_bias, a_log, d_skip, g_ssd_norm, w_out):
    bsz, seq, _ = h.shape
    proj = h @ w_in
    cuts = [ATTN_WIDTH, 2 * ATTN_WIDTH, 3 * ATTN_WIDTH, 3 * ATTN_WIDTH + SSD_WIDTH,
            3 * ATTN_WIDTH + SSD_WIDTH + XBC_WIDTH]
    q, k, v, z, xbc, dt_raw = jnp.split(proj, cuts, axis=-1)

    def heads(t):
        return t.reshape(bsz, seq, ATTN_HEADS, HEAD_DIM).transpose(0, 2, 1, 3)

    attn = _dilated_mixture_attention(heads(q) * HEAD_DIM ** -0.5, heads(k), heads(v))
    attn = attn.transpose(0, 2, 1, 3).reshape(bsz, seq, ATTN_WIDTH)

    pad = CONV_WIDTH // 2
    xbc_p = jnp.pad(xbc, ((0, 0), (pad, pad), (0, 0)))
    conv = conv_b
    for i in range(CONV_WIDTH):
        conv = conv + xbc_p[:, i:i + seq] * conv_w[i]
    xbc = jax.nn.silu(conv)
    gh = (SSD_GROUPS, SSD_HEADS_PER_GROUP)
    xs = xbc[..., :SSD_WIDTH].reshape(bsz, seq, SSD_GROUPS, SSD_HEADS_PER_GROUP, SSD_HEAD_DIM)
    bm = xbc[..., SSD_WIDTH:SSD_WIDTH + SSD_GROUPS * SSD_STATE].reshape(bsz, seq, SSD_GROUPS, SSD_STATE)
    cm = xbc[..., SSD_WIDTH + SSD_GROUPS * SSD_STATE:].reshape(bsz, seq, SSD_GROUPS, SSD_STATE)
    dt = jax.nn.softplus(dt_raw.reshape(bsz, seq, 2, SSD_HEADS) + dt_bias)
    a = -jnp.exp(a_log)

    def flip(t):
        return jnp.flip(t, axis=1)

    y_fwd = _ssd_chunked(xs, dt[:, :, 0].reshape(bsz, seq, *gh), a[0].reshape(gh), bm, cm)
    y_bwd = flip(_ssd_chunked(flip(xs), flip(dt[:, :, 1].reshape(bsz, seq, *gh)),
                              a[1].reshape(gh), flip(bm), flip(cm)))
    y = y_fwd + y_bwd + d_skip.reshape(gh)[:, :, None] * xs
    y = y.reshape(bsz, seq, SSD_WIDTH)
    y = _rmsnorm(y * jax.nn.silu(z), g_ssd_norm)

    return jnp.concatenate([attn, y], axis=-1) @ w_out


def _moe(h, w_router, b_router, w_gate_up, b_gate_up, w_down, b_down):
    bsz, seq, dm = h.shape
    xt = h.reshape(bsz * seq, dm)
    logits = xt @ w_router + b_router
    top_val, top_idx = lax.top_k(logits, TOP_K)
    top_w = jax.nn.softmax(top_val, axis=-1)
    combine = jnp.sum(jax.nn.one_hot(top_idx, N_EXPERTS, dtype=xt.dtype) * top_w[..., None], axis=1)
    out = jnp.zeros_like(xt)
    for e in range(N_EXPERTS):
        gu = xt @ w_gate_up[e] + b_gate_up[e]
        gate = jnp.minimum(gu[:, :EXPERT_FF], SWIGLU_LIMIT)
        up = jnp.clip(gu[:, EXPERT_FF:], -SWIGLU_LIMIT, SWIGLU_LIMIT)
        act = (up + 1.0) * gate * jax.nn.sigmoid(SWIGLU_ALPHA * gate)
        out = out + combine[:, e:e + 1] * (act @ w_down[e] + b_down[e])
    return out.reshape(bsz, seq, dm)


def setup_inputs(seed: int = 0) -> dict:
    key = jax.random.key(seed)
    ks = jax.random.split(key, 24)
    f32 = jnp.float32

    def nrm(k, shape, scale):
        return jax.random.normal(k, shape, f32) * scale

    L = DEPTH
    x = nrm(ks[0], (BATCH, SEQ, D_MODEL), 1.0)
    c = nrm(ks[1], (BATCH, D_MODEL), 1.0)
    w_ada = nrm(ks[2], (L, D_MODEL, N_MOD * D_MODEL), 0.5 * D_MODEL ** -0.5)
    b_ada = nrm(ks[3], (L, N_MOD * D_MODEL), 0.02)
    g_pre_mix = 1.0 + nrm(ks[4], (L, D_MODEL), 0.05)
    g_post_mix = 1.0 + nrm(ks[5], (L, D_MODEL), 0.05)
    w_in_main = nrm(ks[6], (L, D_MODEL, IN_PROJ_WIDTH - 2 * SSD_HEADS), D_MODEL ** -0.5)
    w_in_dt = nrm(ks[7], (L, D_MODEL, 2 * SSD_HEADS), 0.1 * D_MODEL ** -0.5)
    w_in = jnp.concatenate([w_in_main, w_in_dt], axis=-1)
    conv_w = nrm(ks[8], (L, CONV_WIDTH, XBC_WIDTH), CONV_WIDTH ** -0.5)
    conv_b = nrm(ks[9], (L, XBC_WIDTH), 0.02)
    dt0 = jnp.exp(jax.random.uniform(ks[10], (L, 2, SSD_HEADS), f32,
                                     minval=float(np.log(1e-3)), maxval=float(np.log(1e-1))))
    dt_bias = dt0 + jnp.log(-jnp.expm1(-dt0))
    a_log = jnp.log(jax.random.uniform(ks[11], (L, 2, SSD_HEADS), f32, minval=1.0, maxval=16.0))
    d_skip = 1.0 + nrm(ks[12], (L, SSD_HEADS), 0.1)
    g_ssd_norm = 1.0 + nrm(ks[13], (L, SSD_WIDTH), 0.05)
    w_out = nrm(ks[14], (L, MIX_WIDTH, D_MODEL), MIX_WIDTH ** -0.5)
    g_pre_ffn = 1.0 + nrm(ks[15], (L, D_MODEL), 0.05)
    g_post_ffn = 1.0 + nrm(ks[16], (L, D_MODEL), 0.05)
    w_router = nrm(ks[17], (L, D_MODEL, N_EXPERTS), D_MODEL ** -0.5)
    b_router = nrm(ks[18], (L, N_EXPERTS), 0.01)
    w_gate_up = nrm(ks[19], (L, N_EXPERTS, D_MODEL, 2 * EXPERT_FF), D_MODEL ** -0.5)
    b_gate_up = nrm(ks[20], (L, N_EXPERTS, 2 * EXPERT_FF), 0.02)
    w_down = nrm(ks[21], (L, N_EXPERTS, EXPERT_FF, D_MODEL), EXPERT_FF ** -0.5)
    b_down = nrm(ks[22], (L, N_EXPERTS, D_MODEL), 0.02)
    return {'x': x, 'c': c, 'w_ada': w_ada, 'b_ada': b_ada,
            'g_pre_mix': g_pre_mix, 'g_post_mix': g_post_mix, 'w_in': w_in,
            'conv_w': conv_w, 'conv_b': conv_b, 'dt_bias': dt_bias, 'a_log': a_log,
            'd_skip': d_skip, 'g_ssd_norm': g_ssd_norm, 'w_out': w_out,
            'g_pre_ffn': g_pre_ffn, 'g_post_ffn': g_post_ffn,
            'w_router': w_router, 'b_router': b_router, 'w_gate_up': w_gate_up,
            'b_gate_up': b_gate_up, 'w_down': w_down, 'b_down': b_down}


def reference(x, c, w_ada, b_ada, g_pre_mix, g_post_mix, w_in, conv_w, conv_b, dt_bias,
              a_log, d_skip, g_ssd_norm, w_out, g_pre_ffn, g_post_ffn, w_router, b_router,
              w_gate_up, b_gate_up, w_down, b_down):
    f32 = jnp.float32
    out_dtype = x.dtype
    res = x.astype(f32)
    cs = jax.nn.silu(c.astype(f32))
    for layer in range(DEPTH):
        def p(t):
            return t[layer].astype(f32)

        mod = cs @ p(w_ada) + p(b_ada)
        shift_m, scale_m, gate_m, shift_f, scale_f, gate_f = [t[:, None, :] for t in jnp.split(mod, N_MOD, axis=-1)]
        h = _rmsnorm(res, p(g_pre_mix)) * (1.0 + scale_m) + shift_m
        mix = _token_mixer(h, p(w_in), p(conv_w), p(conv_b), p(dt_bias), p(a_log),
                           p(d_skip), p(g_ssd_norm), p(w_out))
        res = res + gate_m * _rmsnorm(mix, p(g_post_mix))
        h = _rmsnorm(res, p(g_pre_ffn)) * (1.0 + scale_f) + shift_f
        ffn = _moe(h, p(w_router), p(b_router), p(w_gate_up), p(b_gate_up), p(w_down), p(b_down))
        res = res + gate_f * _rmsnorm(ffn, p(g_post_ffn))
    return res.astype(out_dtype)
```

```cpp
#include <hip/hip_runtime.h>
#include <cstdio>
#include <cstdint>

typedef unsigned short bf16_t;
typedef short bf16x8 __attribute__((ext_vector_type(8)));
typedef float f32x4 __attribute__((ext_vector_type(4)));
typedef unsigned u32x4 __attribute__((ext_vector_type(4)));

constexpr int BATCH = 2, SEQ = 8192, DM = 1024, TT = BATCH * SEQ;
constexpr int NPROJ = 5632, NPROJ_ALL = 5664;
constexpr int C_Q = 0, C_K = 1024, C_V = 2048, C_Z = 3072, C_XBC = 4096;
constexpr int XBCW = 1536;
constexpr int NEXP = 32, TOPK = 4, FF = 1024;
constexpr float RMS_EPS = 1e-6f;

constexpr size_t MiB = 1u << 20;
constexpr size_t WS_CTL = 0, CTL_BYTES = 1 * MiB;
constexpr size_t WS_MOD = 1 * MiB;
constexpr size_t WS_WIN = 2 * MiB;
constexpr size_t WS_WOUT = 13 * MiB;
constexpr size_t WS_WGU = 17 * MiB;
constexpr size_t WS_WDN = 145 * MiB;
constexpr size_t WS_H = 209 * MiB;
constexpr size_t WS_PROJ = 241 * MiB;
constexpr size_t WS_XC = 417 * MiB;
constexpr size_t WS_DT = 465 * MiB;
constexpr size_t WS_YF = 467 * MiB;
constexpr size_t WS_YB = 531 * MiB;
constexpr size_t WS_MIXIN = 595 * MiB;
constexpr size_t WS_MIX = 659 * MiB;
constexpr size_t WS_TOPW = 723 * MiB;
constexpr size_t WS_SORT = 724 * MiB;
constexpr size_t WS_ACT = 241 * MiB;
constexpr size_t WS_YSLOT = 385 * MiB;
constexpr size_t WS_END = 727 * MiB;

constexpr int CW_ECOUNT = 64;

__device__ __forceinline__ float bf2f(bf16_t v) { return __uint_as_float(((unsigned)v) << 16); }
__device__ __forceinline__ bf16_t f2bf(float f) { unsigned u = __float_as_uint(f); return (bf16_t)((u + 0x7fffu + ((u >> 16) & 1u)) >> 16); }
__device__ __forceinline__ unsigned pk2(float lo, float hi) { return (unsigned)f2bf(lo) | ((unsigned)f2bf(hi) << 16); }
__device__ __forceinline__ float wave_sum(float v) {
#pragma unroll
    for (int o = 1; o < 64; o <<= 1) v += __shfl_xor(v, o);
    return v;
}
__device__ __forceinline__ float siluf(float x) { return x / (1.f + __expf(-x)); }

__global__ void k_mod(const float* __restrict__ c, const float* __restrict__ w_ada, const float* __restrict__ b_ada, float* __restrict__ mod) {
    const int col = blockIdx.x * 256 + threadIdx.x, b = blockIdx.y;
    float acc = b_ada[col];
    for (int k = 0; k < DM; ++k) { const float cv = c[b * DM + k]; acc += siluf(cv) * w_ada[(size_t)k * 6144 + col]; }
    mod[b * 6144 + col] = acc;
}

template <int MODE, int PB>
__global__ void k_transpose(const float* __restrict__ W, bf16_t* __restrict__ WT, int K, int N, int NLIM, size_t w_estride, size_t wt_estride) {
    __shared__ float tile[32][33];
    const int e = blockIdx.z; W += (size_t)e * w_estride; WT += (size_t)e * wt_estride;
    const int n0 = blockIdx.x * 32, k0 = blockIdx.y * 32, tx = threadIdx.x & 31, ty = threadIdx.x >> 5;
#pragma unroll
    for (int i = 0; i < 4; ++i) { const int k = k0 + ty + 8 * i, n = n0 + tx; tile[ty + 8 * i][tx] = (n < N) ? W[(size_t)k * N + n] : 0.f; }
    __syncthreads();
#pragma unroll
    for (int i = 0; i < 4; ++i) {
        const int n = n0 + ty + 8 * i, k = k0 + tx;
        if (n >= NLIM) continue;
        int row = n;
        if (MODE == 1) { const int j = n < FF ? n : n - FF; row = (j / PB) * (2 * PB) + (n < FF ? 0 : PB) + (j % PB); }
        WT[(size_t)row * K + k] = f2bf(tile[tx][ty + 8 * i]);
    }
}

__global__ void k_prenorm(const float* __restrict__ x, const float* __restrict__ g, const float* __restrict__ mod, bf16_t* __restrict__ H) {
    const int lane = threadIdx.x & 63, t = blockIdx.x * 4 + (threadIdx.x >> 6), b = t / SEQ;
    const float* xr = x + (size_t)t * DM; const float* shift = mod + b * 6144; const float* scale = shift + 1024;
    f32x4 v[4]; float ss = 0.f;
#pragma unroll
    for (int j = 0; j < 4; ++j) { v[j] = *(const f32x4*)(xr + 4 * lane + 256 * j); ss += v[j].x * v[j].x + v[j].y * v[j].y + v[j].z * v[j].z + v[j].w * v[j].w; }
    const float r = rsqrtf(wave_sum(ss) * (1.f / DM) + RMS_EPS);
#pragma unroll
    for (int j = 0; j < 4; ++j) {
        const int k = 4 * lane + 256 * j; const f32x4 gg = *(const f32x4*)(g + k), sc = *(const f32x4*)(scale + k), sh = *(const f32x4*)(shift + k);
        const f32x4 h = v[j] * r * gg * (sc + 1.f) + sh;
        uint2 o; o.x = pk2(h.x, h.y); o.y = pk2(h.z, h.w);
        *(uint2*)(H + (size_t)t * DM + k) = o;
    }
}

__global__ void k_dt(const bf16_t* __restrict__ H, const float* __restrict__ w_in, const float* __restrict__ dt_bias, float* __restrict__ DT) {
    const int gid = blockIdx.x * 256 + threadIdx.x, t = gid >> 5, j = gid & 31;
    const bf16_t* hr = H + (size_t)t * DM; float acc = 0.f;
    for (int k = 0; k < DM; ++k) acc += bf2f(hr[k]) * w_in[(size_t)k * NPROJ_ALL + NPROJ + j];
    const float v = acc + dt_bias[j];
    DT[gid] = v > 20.f ? v : log1pf(__expf(v));
}

constexpr int G_BM = 128, G_BK = 32, G_HT = G_BM * G_BK;
__device__ __forceinline__ void gemm128_tile(const bf16_t* a0, const bf16_t* a1, const bf16_t* b0, const bf16_t* b1, int K, bf16_t* shm, f32x4 (&acc)[4][4]) {
    const int tid = threadIdx.x, wid = tid >> 6, lane = tid & 63, wr = wid >> 1, wc = wid & 1, fr = lane & 15, fq = lane >> 4;
    bf16_t* SA = shm; bf16_t* SB = shm + G_HT;
    const int c = ((tid * 16) % 64) / 2;
    const bf16_t* ap[2] = {a0 + c, a1 + c}; const bf16_t* bp[2] = {b0 + c, b1 + c};
#pragma unroll
    for (int m = 0; m < 4; ++m)
#pragma unroll
        for (int n = 0; n < 4; ++n) acc[m][n] = (f32x4){0.f, 0.f, 0.f, 0.f};
    for (int t = 0; t < K / G_BK; ++t) {
#pragma unroll
        for (int i = 0; i < 2; ++i) {
            const int b = tid * 16 + i * 4096;
            __builtin_amdgcn_global_load_lds((const unsigned*)(ap[i] + t * G_BK), (__attribute__((address_space(3))) unsigned*)((char*)SA + b), 16, 0, 0);
            __builtin_amdgcn_global_load_lds((const unsigned*)(bp[i] + t * G_BK), (__attribute__((address_space(3))) unsigned*)((char*)SB + b), 16, 0, 0);
        }
        asm volatile("s_waitcnt vmcnt(0)" ::: "memory"); __syncthreads();
        bf16x8 At[4], Bl[4];
#pragma unroll
        for (int m = 0; m < 4; ++m) At[m] = *reinterpret_cast<const bf16x8*>((char*)SA + (wr * 64 + m * 16 + fr) * G_BK * 2 + fq * 16);
#pragma unroll
        for (int n = 0; n < 4; ++n) Bl[n] = *reinterpret_cast<const bf16x8*>((char*)SB + (wc * 64 + n * 16 + fr) * G_BK * 2 + fq * 16);
        asm volatile("s_waitcnt lgkmcnt(0)" ::: "memory"); __builtin_amdgcn_sched_barrier(0);
#pragma unroll
        for (int m = 0; m < 4; ++m)
#pragma unroll
            for (int n = 0; n < 4; ++n) acc[m][n] = __builtin_amdgcn_mfma_f32_16x16x32_bf16(At[m], Bl[n], acc[m][n], 0, 0, 0);
        __syncthreads();
    }
}

__global__ __launch_bounds__(256, 2) void k_gemm_inproj(const bf16_t* __restrict__ H, const bf16_t* __restrict__ WT, bf16_t* __restrict__ PROJ) {
    extern __shared__ __attribute__((aligned(16))) bf16_t shm[];
    const int brow = blockIdx.y * 128, bcol = blockIdx.x * 128, tid = threadIdx.x;
    const int r0 = (tid * 16) / 64, r1 = r0 + 64;
    f32x4 acc[4][4];
    gemm128_tile(H + (size_t)(brow + r0) * DM, H + (size_t)(brow + r1) * DM, WT + (size_t)(bcol + r0) * DM, WT + (size_t)(bcol + r1) * DM, DM, shm, acc);
    const int wid = tid >> 6, lane = tid & 63, wr = wid >> 1, wc = wid & 1, fr = lane & 15, fq = lane >> 4;
    const float sc = (bcol < 1024) ? 0.125f : 1.f;
#pragma unroll
    for (int m = 0; m < 4; ++m)
#pragma unroll
        for (int n = 0; n < 4; ++n)
#pragma unroll
            for (int j = 0; j < 4; ++j) PROJ[(size_t)(brow + wr * 64 + m * 16 + fq * 4 + j) * NPROJ + bcol + wc * 64 + n * 16 + fr] = f2bf(acc[m][n][j] * sc);
}

__global__ __launch_bounds__(256, 2) void k_gemm_outproj(const bf16_t* __restrict__ A, const bf16_t* __restrict__ WT, float* __restrict__ MIX) {
    extern __shared__ __attribute__((aligned(16))) bf16_t shm[];
    const int brow = blockIdx.y * 128, bcol = blockIdx.x * 128, tid = threadIdx.x;
    const int r0 = (tid * 16) / 64, r1 = r0 + 64;
    f32x4 acc[4][4];
    gemm128_tile(A + (size_t)(brow + r0) * 2048, A + (size_t)(brow + r1) * 2048, WT + (size_t)(bcol + r0) * 2048, WT + (size_t)(bcol + r1) * 2048, 2048, shm, acc);
    const int wid = tid >> 6, lane = tid & 63, wr = wid >> 1, wc = wid & 1, fr = lane & 15, fq = lane >> 4;
#pragma unroll
    for (int m = 0; m < 4; ++m)
#pragma unroll
        for (int n = 0; n < 4; ++n)
#pragma unroll
            for (int j = 0; j < 4; ++j) MIX[(size_t)(brow + wr * 64 + m * 16 + fq * 4 + j) * DM + bcol + wc * 64 + n * 16 + fr] = acc[m][n][j];
}

__global__ void k_attn_naive(const bf16_t* __restrict__ PROJ, bf16_t* __restrict__ MIXIN) {
    const int lane = threadIdx.x & 63, gw = blockIdx.x * 4 + (threadIdx.x >> 6);
    const int t = gw >> 4, h = gw & 15, b = t / SEQ, pos = t % SEQ;
    const float q = bf2f(PROJ[(size_t)t * NPROJ + C_Q + h * 64 + lane]);
    const float slope = exp2f(-0.5f * (float)(h + 1));
    float m = -INFINITY, l = 0.f, o = 0.f;
    for (int g = 0; g < 3; ++g) {
        const int d = (g == 0) ? 1 : (g == 1 ? 4 : 16);
        for (int j = -64; j <= 64; ++j) {
            const int kp = pos + j * d;
            if (kp < 0 || kp >= SEQ) continue;
            const size_t tk = (size_t)(b * SEQ + kp) * NPROJ;
            const float kk = bf2f(PROJ[tk + C_K + h * 64 + lane]), vv = bf2f(PROJ[tk + C_V + h * 64 + lane]);
            const float s = wave_sum(q * kk) - slope * (float)((j < 0 ? -j : j) * d);
            const float mn = fmaxf(m, s), sc = __expf(m - mn), p = __expf(s - mn);
            l = l * sc + p; o = o * sc + p * vv; m = mn;
        }
    }
    MIXIN[(size_t)t * 2048 + h * 64 + lane] = f2bf(o / l);
}

__global__ void k_conv(const bf16_t* __restrict__ PROJ, const float* __restrict__ conv_w, const float* __restrict__ conv_b, bf16_t* __restrict__ XC) {
    const int gid = blockIdx.x * 256 + threadIdx.x, t = gid / XBCW, c = gid % XBCW, pos = t % SEQ;
    float acc = conv_b[c];
#pragma unroll
    for (int i = 0; i < 5; ++i) { const int p = pos + i - 2; if (p >= 0 && p < SEQ) acc += bf2f(PROJ[(size_t)(t + i - 2) * NPROJ + C_XBC + c]) * conv_w[i * XBCW + c]; }
    XC[(size_t)t * XBCW + c] = f2bf(siluf(acc));
}

__global__ void k_ssd_seq(const bf16_t* __restrict__ XC, const float* __restrict__ DT, const float* __restrict__ a_log, float* __restrict__ YF, float* __restrict__ YB) {
    const int lane = threadIdx.x & 63, gw = blockIdx.x * 4 + (threadIdx.x >> 6);
    const int p = gw & 63, hd = (gw >> 6) & 15, dir = (gw >> 10) & 1, b = gw >> 11, g = hd >> 3;
    const float a = -__expf(a_log[dir * 16 + hd]);
    float* Y = dir ? YB : YF;
    float h0 = 0.f, h1 = 0.f;
#pragma unroll 4
    for (int step = 0; step < SEQ; ++step) {
        const int pos = dir ? (SEQ - 1 - step) : step; const size_t t = (size_t)b * SEQ + pos;
        const float dtv = DT[t * 32 + dir * 16 + hd], xv = bf2f(XC[t * XBCW + hd * 64 + p]);
        const float B0 = bf2f(XC[t * XBCW + 1024 + g * 128 + lane]), B1 = bf2f(XC[t * XBCW + 1024 + g * 128 + 64 + lane]);
        const float C0 = bf2f(XC[t * XBCW + 1280 + g * 128 + lane]), C1 = bf2f(XC[t * XBCW + 1280 + g * 128 + 64 + lane]);
        const float dec = __expf(a * dtv), xd = dtv * xv;
        h0 = h0 * dec + xd * B0; h1 = h1 * dec + xd * B1;
        const float y = wave_sum(C0 * h0 + C1 * h1);
        if (lane == 0) Y[t * DM + hd * 64 + p] = y;
    }
}

__global__ void k_ssd_gate(const float* __restrict__ YF, const float* __restrict__ YB, const bf16_t* __restrict__ XC, const bf16_t* __restrict__ PROJ,
                           const float* __restrict__ d_skip, const float* __restrict__ g_norm, bf16_t* __restrict__ MIXIN) {
    const int lane = threadIdx.x & 63, t = blockIdx.x * 4 + (threadIdx.x >> 6);
    float y[16]; float ss = 0.f;
#pragma unroll
    for (int j = 0; j < 4; ++j)
#pragma unroll
        for (int i = 0; i < 4; ++i) {
            const int c = 4 * lane + 256 * j + i;
            const float xs = bf2f(XC[(size_t)t * XBCW + c]), z = bf2f(PROJ[(size_t)t * NPROJ + C_Z + c]);
            float v = YF[(size_t)t * DM + c] + YB[(size_t)t * DM + c] + d_skip[c >> 6] * xs;
            v *= siluf(z); y[j * 4 + i] = v; ss += v * v;
        }
    const float r = rsqrtf(wave_sum(ss) * (1.f / DM) + RMS_EPS);
#pragma unroll
    for (int j = 0; j < 4; ++j)
#pragma unroll
        for (int i = 0; i < 4; ++i) { const int c = 4 * lane + 256 * j + i; MIXIN[(size_t)t * 2048 + 1024 + c] = f2bf(y[j * 4 + i] * r * g_norm[c]); }
}

__global__ void k_postmix(const float* __restrict__ x, const float* __restrict__ MIX, const float* __restrict__ mod, const float* __restrict__ g_post, const float* __restrict__ g_pre,
                          const float* __restrict__ w_router, const float* __restrict__ b_router, float* __restrict__ res, bf16_t* __restrict__ H2,
                          unsigned* __restrict__ ecount, int* __restrict__ sorted, float* __restrict__ topw) {
    const int lane = threadIdx.x & 63, t = blockIdx.x * 4 + (threadIdx.x >> 6), b = t / SEQ;
    const float* mb = mod + b * 6144;
    float mv[16], rv[16], hv[16]; float ss = 0.f;
#pragma unroll
    for (int j = 0; j < 4; ++j) { const f32x4 v = *(const f32x4*)(MIX + (size_t)t * DM + 4 * lane + 256 * j); mv[4 * j] = v.x; mv[4 * j + 1] = v.y; mv[4 * j + 2] = v.z; mv[4 * j + 3] = v.w; ss += v.x * v.x + v.y * v.y + v.z * v.z + v.w * v.w; }
    const float r = rsqrtf(wave_sum(ss) * (1.f / DM) + RMS_EPS);
    float ss2 = 0.f;
#pragma unroll
    for (int j = 0; j < 4; ++j)
#pragma unroll
        for (int i = 0; i < 4; ++i) { const int c = 4 * lane + 256 * j + i; const float v = x[(size_t)t * DM + c] + mb[2048 + c] * (mv[4 * j + i] * r * g_post[c]); rv[4 * j + i] = v; ss2 += v * v; }
    const float r2 = rsqrtf(wave_sum(ss2) * (1.f / DM) + RMS_EPS);
#pragma unroll
    for (int j = 0; j < 4; ++j) {
        const int c0 = 4 * lane + 256 * j;
#pragma unroll
        for (int i = 0; i < 4; ++i) { const int c = c0 + i; hv[4 * j + i] = rv[4 * j + i] * r2 * g_pre[c] * (1.f + mb[4096 + c]) + mb[3072 + c]; }
        *(f32x4*)(res + (size_t)t * DM + c0) = (f32x4){rv[4 * j], rv[4 * j + 1], rv[4 * j + 2], rv[4 * j + 3]};
        uint2 o; o.x = pk2(hv[4 * j], hv[4 * j + 1]); o.y = pk2(hv[4 * j + 2], hv[4 * j + 3]);
        *(uint2*)(H2 + (size_t)t * DM + c0) = o;
    }
    float lg[32];
#pragma unroll
    for (int e = 0; e < 32; ++e) lg[e] = 0.f;
#pragma unroll
    for (int j = 0; j < 4; ++j)
#pragma unroll
        for (int i = 0; i < 4; ++i) { const int c = 4 * lane + 256 * j + i; const float hvv = hv[4 * j + i]; const float* wr = w_router + (size_t)c * 32;
#pragma unroll
            for (int e = 0; e < 32; ++e) lg[e] += hvv * wr[e]; }
#pragma unroll
    for (int e = 0; e < 32; ++e) lg[e] = wave_sum(lg[e]) + b_router[e];
    int ti[4]; float tv[4];
#pragma unroll
    for (int k = 0; k < 4; ++k) {
        float best = -INFINITY; int bi = 0;
#pragma unroll
        for (int e = 0; e < 32; ++e) { if (lg[e] > best) { best = lg[e]; bi = e; } }
        ti[k] = bi; tv[k] = best;
#pragma unroll
        for (int e = 0; e < 32; ++e) if (e == bi) lg[e] = -INFINITY;
    }
    const float e1 = __expf(tv[1] - tv[0]), e2 = __expf(tv[2] - tv[0]), e3 = __expf(tv[3] - tv[0]), inv = 1.f / (1.f + e1 + e2 + e3);
    const float w4[4] = {inv, e1 * inv, e2 * inv, e3 * inv};
    if (lane < 4) {
        int e = ti[0]; float w = w4[0];
        if (lane == 1) { e = ti[1]; w = w4[1]; } else if (lane == 2) { e = ti[2]; w = w4[2]; } else if (lane == 3) { e = ti[3]; w = w4[3]; }
        const unsigned rank = atomicAdd(&ecount[e], 1u);
        sorted[e * TT + rank] = t * 4 + lane;
        topw[t * 4 + lane] = w;
    }
}

__device__ __forceinline__ bool moe_tile(const unsigned* ecount, int bx, int& e, int& row0, int& nvalid, int& act_row0) {
    int cum = 0;
    for (int i = 0; i < NEXP; ++i) {
        const int cnt = (int)ecount[i], nt = (cnt + 127) >> 7;
        if (bx < cum + nt) { e = i; row0 = (bx - cum) * 128; nvalid = min(128, cnt - row0); act_row0 = cum * 128 + row0; return true; }
        cum += nt;
    }
    return false;
}

__global__ __launch_bounds__(256, 2) void k_moe_up(const bf16_t* __restrict__ H2, const bf16_t* __restrict__ WGU, const float* __restrict__ b_gu, const unsigned* __restrict__ ecount,
                                                    const int* __restrict__ sorted, bf16_t* __restrict__ ACT) {
    extern __shared__ __attribute__((aligned(16))) bf16_t shm[];
    int e, row0, nvalid, act_row0;
    if (!moe_tile(ecount, blockIdx.y, e, row0, nvalid, act_row0)) return;
    const int bcol = blockIdx.x * 128, tid = threadIdx.x;
    const int r0 = (tid * 16) / 64, r1 = r0 + 64;
    const int* sl = sorted + e * TT + row0;
    const int tok0 = sl[r0 < nvalid ? r0 : 0] >> 2, tok1 = sl[r1 < nvalid ? r1 : 0] >> 2;
    const bf16_t* W = WGU + (size_t)e * 2048 * DM;
    f32x4 acc[4][4];
    gemm128_tile(H2 + (size_t)tok0 * DM, H2 + (size_t)tok1 * DM, W + (size_t)(bcol + r0) * DM, W + (size_t)(bcol + r1) * DM, DM, shm, acc);
    const int wid = tid >> 6, lane = tid & 63, wr = wid >> 1, wc = wid & 1, fr = lane & 15, fq = lane >> 4;
    const int blk = (bcol + wc * 64) / 64;
    const float* bg = b_gu + (size_t)e * 2048;
#pragma unroll
    for (int m = 0; m < 4; ++m)
#pragma unroll
        for (int n = 0; n < 2; ++n) {
            const int col = blk * 32 + n * 16 + fr; const float bgate = bg[col], bup = bg[FF + col];
#pragma unroll
            for (int j = 0; j < 4; ++j) {
                const int r = wr * 64 + m * 16 + fq * 4 + j;
                const float gate = fminf(acc[m][n][j] + bgate, 7.f), up = fminf(fmaxf(acc[m][n + 2][j] + bup, -7.f), 7.f);
                const float a = (up + 1.f) * gate / (1.f + __expf(-1.702f * gate));
                ACT[(size_t)(act_row0 + r) * FF + col] = f2bf(a);
            }
        }
}

__global__ __launch_bounds__(256, 2) void k_moe_down(const bf16_t* __restrict__ ACT, const bf16_t* __restrict__ WDN, const float* __restrict__ b_dn, const unsigned* __restrict__ ecount,
                                                      const int* __restrict__ sorted, const float* __restrict__ topw, bf16_t* __restrict__ YSLOT) {
    extern __shared__ __attribute__((aligned(16))) bf16_t shm[];
    int e, row0, nvalid, act_row0;
    if (!moe_tile(ecount, blockIdx.y, e, row0, nvalid, act_row0)) return;
    const int bcol = blockIdx.x * 128, tid = threadIdx.x;
    const int r0 = (tid * 16) / 64, r1 = r0 + 64;
    const bf16_t* W = WDN + (size_t)e * DM * FF;
    f32x4 acc[4][4];
    gemm128_tile(ACT + (size_t)(act_row0 + r0) * FF, ACT + (size_t)(act_row0 + r1) * FF, W + (size_t)(bcol + r0) * FF, W + (size_t)(bcol + r1) * FF, FF, shm, acc);
    const int wid = tid >> 6, lane = tid & 63, wr = wid >> 1, wc = wid & 1, fr = lane & 15, fq = lane >> 4;
    const int* sl = sorted + e * TT + row0;
#pragma unroll
    for (int m = 0; m < 4; ++m)
#pragma unroll
        for (int j = 0; j < 4; ++j) {
            const int r = wr * 64 + m * 16 + fq * 4 + j;
            if (r >= nvalid) continue;
            const int slot = sl[r]; const float w = topw[slot];
#pragma unroll
            for (int n = 0; n < 4; ++n) { const int col = bcol + wc * 64 + n * 16 + fr; YSLOT[(size_t)slot * DM + col] = f2bf(w * (acc[m][n][j] + b_dn[e * DM + col])); }
        }
}

__global__ void k_final(const bf16_t* __restrict__ YSLOT, const float* __restrict__ mod, const float* __restrict__ g_post, float* __restrict__ out) {
    const int lane = threadIdx.x & 63, t = blockIdx.x * 4 + (threadIdx.x >> 6), b = t / SEQ;
    const float* gate = mod + b * 6144 + 5120;
    float f[16]; float ss = 0.f;
#pragma unroll
    for (int j = 0; j < 4; ++j)
#pragma unroll
        for (int i = 0; i < 4; ++i) {
            const int c = 4 * lane + 256 * j + i; float s = 0.f;
#pragma unroll
            for (int k = 0; k < 4; ++k) s += bf2f(YSLOT[(size_t)(t * 4 + k) * DM + c]);
            f[4 * j + i] = s; ss += s * s;
        }
    const float r = rsqrtf(wave_sum(ss) * (1.f / DM) + RMS_EPS);
#pragma unroll
    for (int j = 0; j < 4; ++j)
#pragma unroll
        for (int i = 0; i < 4; ++i) { const int c = 4 * lane + 256 * j + i; out[(size_t)t * DM + c] += gate[c] * (f[4 * j + i] * r * g_post[c]); }
}

extern "C" void kernel_launch(void* const* d_in, const int* in_sizes, int n_in, void* d_out, int out_size, void* d_ws, size_t ws_size, hipStream_t stream) {
    if (ws_size < WS_END) { fprintf(stderr, "workspace too small: %zu < %zu\n", ws_size, (size_t)WS_END); return; }
    const float* x = (const float*)d_in[0]; const float* c = (const float*)d_in[1]; const float* w_ada = (const float*)d_in[2]; const float* b_ada = (const float*)d_in[3];
    const float* g_pre_mix = (const float*)d_in[4]; const float* g_post_mix = (const float*)d_in[5]; const float* w_in = (const float*)d_in[6];
    const float* conv_w = (const float*)d_in[7]; const float* conv_b = (const float*)d_in[8]; const float* dt_bias = (const float*)d_in[9]; const float* a_log = (const float*)d_in[10];
    const float* d_skip = (const float*)d_in[11]; const float* g_ssd = (const float*)d_in[12]; const float* w_out = (const float*)d_in[13];
    const float* g_pre_ffn = (const float*)d_in[14]; const float* g_post_ffn = (const float*)d_in[15]; const float* w_router = (const float*)d_in[16]; const float* b_router = (const float*)d_in[17];
    const float* w_gu = (const float*)d_in[18]; const float* b_gu = (const float*)d_in[19]; const float* w_dn = (const float*)d_in[20]; const float* b_dn = (const float*)d_in[21];
    float* out = (float*)d_out; char* ws = (char*)d_ws;
    unsigned* ctl = (unsigned*)(ws + WS_CTL); float* mod = (float*)(ws + WS_MOD);
    bf16_t* WIN = (bf16_t*)(ws + WS_WIN); bf16_t* WOUT = (bf16_t*)(ws + WS_WOUT); bf16_t* WGU = (bf16_t*)(ws + WS_WGU); bf16_t* WDN = (bf16_t*)(ws + WS_WDN);
    bf16_t* H = (bf16_t*)(ws + WS_H); bf16_t* PROJ = (bf16_t*)(ws + WS_PROJ); bf16_t* XC = (bf16_t*)(ws + WS_XC); float* DT = (float*)(ws + WS_DT);
    float* YF = (float*)(ws + WS_YF); float* YB = (float*)(ws + WS_YB); bf16_t* MIXIN = (bf16_t*)(ws + WS_MIXIN); float* MIX = (float*)(ws + WS_MIX);
    float* TOPW = (float*)(ws + WS_TOPW); int* SORT = (int*)(ws + WS_SORT); bf16_t* ACT = (bf16_t*)(ws + WS_ACT); bf16_t* YSLOT = (bf16_t*)(ws + WS_YSLOT);

    hipMemsetAsync(ws + WS_CTL, 0, CTL_BYTES, stream);
    k_mod<<<dim3(6144 / 256, 2), 256, 0, stream>>>(c, w_ada, b_ada, mod);
    k_transpose<0, 1><<<dim3(NPROJ_ALL / 32, DM / 32, 1), 256, 0, stream>>>(w_in, WIN, DM, NPROJ_ALL, NPROJ, 0, 0);
    k_transpose<0, 1><<<dim3(DM / 32, 2048 / 32, 1), 256, 0, stream>>>(w_out, WOUT, 2048, DM, DM, 0, 0);
    k_transpose<1, 32><<<dim3(2048 / 32, DM / 32, NEXP), 256, 0, stream>>>(w_gu, WGU, DM, 2048, 2048, (size_t)DM * 2048, (size_t)2048 * DM);
    k_transpose<0, 1><<<dim3(DM / 32, FF / 32, NEXP), 256, 0, stream>>>(w_dn, WDN, FF, DM, DM, (size_t)FF * DM, (size_t)DM * FF);
    k_prenorm<<<TT / 4, 256, 0, stream>>>(x, g_pre_mix, mod, H);
    k_dt<<<TT * 32 / 256, 256, 0, stream>>>(H, w_in, dt_bias, DT);
    const int shm_g = 2 * G_HT * 2;
    k_gemm_inproj<<<dim3(NPROJ / 128, TT / 128), 256, shm_g, stream>>>(H, WIN, PROJ);
    k_attn_naive<<<TT * 16 / 4, 256, 0, stream>>>(PROJ, MIXIN);
    k_conv<<<TT * XBCW / 256, 256, 0, stream>>>(PROJ, conv_w, conv_b, XC);
    k_ssd_seq<<<4096 / 4, 256, 0, stream>>>(XC, DT, a_log, YF, YB);
    k_ssd_gate<<<TT / 4, 256, 0, stream>>>(YF, YB, XC, PROJ, d_skip, g_ssd, MIXIN);
    k_gemm_outproj<<<dim3(DM / 128, TT / 128), 256, shm_g, stream>>>(MIXIN, WOUT, MIX);
    k_postmix<<<TT / 4, 256, 0, stream>>>(x, MIX, mod, g_post_mix, g_pre_ffn, w_router, b_router, out, H, ctl + CW_ECOUNT, SORT, TOPW);
    k_moe_up<<<dim3(2048 / 128, 544), 256, shm_g, stream>>>(H, WGU, b_gu, ctl + CW_ECOUNT, SORT, ACT);
    k_moe_down<<<dim3(DM / 128, 544), 256, shm_g, stream>>>(ACT, WDN, b_dn, ctl + CW_ECOUNT, SORT, TOPW, YSLOT);
    k_final<<<TT / 4, 256, 0, stream>>>(YSLOT, mod, g_post_ffn, out);
}
```

```cpp
#include <hip/hip_runtime.h>
#include <cstdio>
#include <cstdint>

#define LAS __attribute__((address_space(3)))
#define GAS __attribute__((address_space(1)))
typedef unsigned short bf16_t;
typedef short bf16x8 __attribute__((ext_vector_type(8)));
typedef float f32x4 __attribute__((ext_vector_type(4)));
typedef unsigned u32x4 __attribute__((ext_vector_type(4)));
typedef unsigned u32x2 __attribute__((ext_vector_type(2)));
typedef GAS unsigned gu32;

#ifndef DUP_PHASE
#define DUP_PHASE -1
#endif
#ifndef MK_N_LAUNCHES
#define MK_N_LAUNCHES 1
#endif
constexpr int N_PHASES = 12;

constexpr int BATCH = 2, SEQ = 8192, DM = 1024, TT = BATCH * SEQ;
constexpr int NPROJ = 5632, NPROJ_ALL = 5664, NPROJ_PAD = 5888;
constexpr int C_Q = 0, C_K = 1024, C_V = 2048, C_Z = 3072, C_XBC = 4096;
constexpr int XBCW = 1536;
constexpr int NEXP = 32, FF = 1024;
constexpr float RMS_EPS = 1e-6f;
constexpr int NWAVES = 8, NTHREADS = 512;

constexpr size_t MiB = 1u << 20;
constexpr size_t WS_CTL = 0, CTL_BYTES = 65536;
constexpr size_t WS_MOD = 1 * MiB;
constexpr size_t WS_WIN = 2 * MiB;
constexpr size_t WS_WOUT = 14 * MiB;
constexpr size_t WS_WGU = 18 * MiB;
constexpr size_t WS_WDN = 146 * MiB;
constexpr size_t WS_H = 210 * MiB;
constexpr size_t WS_PROJ = 242 * MiB;
constexpr size_t WS_XC = 418 * MiB;
constexpr size_t WS_DT = 466 * MiB;
constexpr size_t WS_STATES = 468 * MiB;
constexpr size_t WS_CUM = 532 * MiB;
constexpr size_t WS_CHDEC = 534 * MiB;
constexpr size_t WS_MIXIN = 596 * MiB;
constexpr size_t WS_MIX = 660 * MiB;
constexpr size_t WS_TOPW = 724 * MiB;
constexpr size_t WS_SORT = 725 * MiB;
constexpr size_t WS_SORTW = 536 * MiB;
constexpr size_t WS_RR = 538 * MiB;
constexpr size_t WS_ACT = 242 * MiB;
constexpr size_t WS_YSLOT = 386 * MiB;
constexpr size_t WS_WRT = 535 * MiB;
constexpr size_t WS_OPART = 728 * MiB;
constexpr size_t WS_LSE = 824 * MiB;
constexpr size_t WS_HPREV = 828 * MiB;
constexpr size_t WS_RES = 892 * MiB;
constexpr size_t WS_END = 956 * MiB;

constexpr int CW_ECOUNT = 64;
constexpr int CW_MODCNT = 1024;
constexpr int CW_BAR = 4096;
constexpr int CW_FQ = 9216, CW_MQ = 9280;

constexpr int RING_BYTES = 131072;
constexpr int LDSCTL_OFF = RING_BYTES;
constexpr int LDS_BYTES = 147456;

__device__ __forceinline__ float bf2f(bf16_t v) { return __uint_as_float(((unsigned)v) << 16); }
__device__ __forceinline__ bf16_t f2bf(float f) { unsigned u = __float_as_uint(f); return (bf16_t)((u + 0x7fffu + ((u >> 16) & 1u)) >> 16); }
typedef float f32x2_t __attribute__((ext_vector_type(2))); typedef __bf16 bf16x2_t __attribute__((ext_vector_type(2)));
__device__ __forceinline__ unsigned pk2(float lo, float hi) { f32x2_t v = {lo, hi}; bf16x2_t b = __builtin_convertvector(v, bf16x2_t); return __builtin_bit_cast(unsigned, b); }
__device__ __forceinline__ float wave_sum(float v) {
#pragma unroll
    for (int o = 1; o < 64; o <<= 1) v += __shfl_xor(v, o);
    return v;
}
__device__ __forceinline__ float siluf(float x) { return x * __builtin_amdgcn_rcpf(1.f + __expf(-x)); }
#define LDS_WAIT() asm volatile("s_waitcnt lgkmcnt(0)" ::: "memory")
__device__ __forceinline__ int lane_id_fresh() { int l; asm volatile("v_mbcnt_lo_u32_b32 %0, -1, 0\n\tv_mbcnt_hi_u32_b32 %0, -1, %0" : "=v"(l)); return l; }

namespace pg8 {
constexpr int BM = 256, BK = 64, HALF = 128, HTB = HALF * BK * 2, STAGE_BYTES = 8 * HTB;
__host__ __device__ __forceinline__ int lds_byte(int r, int c) { const int st = (r >> 4) * 2 + (c >> 5), rr = r & 15, cc = c & 31, ob = rr * 64 + cc * 2; return st * 1024 + (ob ^ (((ob >> 9) & 1) << 5)); }
__host__ __device__ __forceinline__ void stage_rc(int b, int& R, int& C) { const int st = b / 1024, sb = b % 1024, swz = sb ^ (((sb >> 9) & 1) << 5); R = (st >> 1) * 16 + swz / 64; C = (st & 1) * 32 + (swz % 64) / 2; }
__host__ __device__ __forceinline__ int perm32(int rho) { const int n = rho >> 4, i = rho & 15; return 8 * (i >> 2) + 4 * n + (i & 3); }

struct Unit { int pm, pn, arow0, e, nvalid, lrow0; size_t boff; };
struct Gemm { const bf16_t* A; const bf16_t* Bt; int K; };

template <int M_, int N_, int K_>
struct DenseOrder {
    static constexpr int nM = M_ / BM, nN = N_ / BM, nwg = nM * nN, K = K_;
    int G, c;
    __device__ void init(int G_, int c_) { G = G_; c = c_; }
    __device__ __forceinline__ bool next(int i, Unit& u) const {
        const long L = (long)i * G + c; if (L >= nwg) return false;
        int wgid = (int)L; { const int q = nwg / 8, r = nwg % 8, xcd = wgid % 8, off = wgid / 8; wgid = (xcd < r ? xcd * (q + 1) : r * (q + 1) + (xcd - r) * q) + off; }
        const int nig = 8 * nN, gid = wgid / nig, fm = gid * 8, gsz = (nM - fm) < 8 ? (nM - fm) : 8;
        u.pm = fm + ((wgid % nig) % gsz); u.pn = (wgid % nig) / gsz; u.arow0 = u.pm * BM; u.e = 0; u.nvalid = BM; u.lrow0 = 0; u.boff = (size_t)u.pn * BM * K * 2; return true;
    }
    __device__ __forceinline__ void a_off(const Unit& u, const int (&R)[2], const int (&C)[2], unsigned (&off)[2][2]) const {
#pragma unroll
        for (int h = 0; h < 2; ++h)
#pragma unroll
            for (int i = 0; i < 2; ++i) off[h][i] = (unsigned)(((size_t)(u.arow0 + h * HALF + R[i]) * K + C[i]) * 2);
    }
};
struct MoeOrder {
    const LAS int* tcum; const LAS int* cnt; const LAS int* texp; const int* sorted; int nNsh, G, c, K; size_t estride; bool gather;
    __device__ __forceinline__ bool next(int i, Unit& u) const {
        const int L = i * G + c, NT = tcum[NEXP]; if (L >= (NT << nNsh)) return false;
        const int rt = L >> nNsh; u.pn = L & ((1 << nNsh) - 1); u.pm = rt;
        const int e = texp[rt];
        u.e = e; u.lrow0 = (rt - tcum[e]) * BM; u.nvalid = min(BM, cnt[e] - u.lrow0); u.arow0 = rt * BM;
        u.boff = (size_t)e * estride + (size_t)u.pn * BM * K * 2; return true;
    }
    __device__ __forceinline__ void a_off(const Unit& u, const int (&R)[2], const int (&C)[2], unsigned (&off)[2][2]) const {
#pragma unroll
        for (int h = 0; h < 2; ++h)
#pragma unroll
            for (int i = 0; i < 2; ++i) {
                const int r = h * HALF + R[i];
                int row;
                if (gather) { const int rr = r < u.nvalid ? r : 0; row = sorted[u.e * TT + u.lrow0 + rr] >> 2; } else row = u.arow0 + r;
                off[h][i] = (unsigned)(((size_t)row * K + C[i]) * 2);
            }
    }
};

__device__ __forceinline__ unsigned cvt_pk_bf16(float lo, float hi) { f32x2_t v = {lo, hi}; bf16x2_t b = __builtin_convertvector(v, bf16x2_t); return __builtin_bit_cast(unsigned, b); }

constexpr int PF_OFF = 131072 + 10240, PF_BYTES = 3072;
struct EpiInproj {
    static constexpr bool PERM = true, PREFETCH = false, MIDSCALE = false;
    bf16_t* O; float* DT; const float* dt_bias;
    __device__ __forceinline__ void operator()(const f32x4 (&acc)[2][2][4][2], const Unit& u, int wr, int wc, int fr, int fq, const LAS unsigned char*) const {
        const int row0 = u.arow0 + wr * 64 + fr;
        if (u.pn < NPROJ / BM) {
            const float sc = (u.pn < 4) ? 0.125f * 1.4426950408889634f : 1.f;
            const int col0 = u.pn * BM + wc * 32 + 8 * fq;
#pragma unroll
            for (int ai = 0; ai < 2; ++ai)
#pragma unroll
                for (int m = 0; m < 4; ++m) { bf16_t* rowp = O + (size_t)(row0 + ai * HALF + m * 16) * NPROJ + col0;
#pragma unroll
                    for (int bj = 0; bj < 2; ++bj) { const f32x4 v0 = acc[ai][bj][m][0] * sc, v1 = acc[ai][bj][m][1] * sc;
                        u32x4 w; w.x = cvt_pk_bf16(v0[0], v0[1]); w.y = cvt_pk_bf16(v0[2], v0[3]); w.z = cvt_pk_bf16(v1[0], v1[1]); w.w = cvt_pk_bf16(v1[2], v1[3]);
                        *(u32x4*)(rowp + bj * HALF) = w; } }
        } else if (wc == 0) {
            const int c0 = 8 * fq; const f32x4 b0 = *(const f32x4*)(dt_bias + c0), b1 = *(const f32x4*)(dt_bias + c0 + 4);
#pragma unroll
            for (int ai = 0; ai < 2; ++ai)
#pragma unroll
                for (int m = 0; m < 4; ++m) { float* rowp = DT + (size_t)(row0 + ai * HALF + m * 16) * 32 + c0;
                    f32x4 v0 = acc[ai][0][m][0] + b0, v1 = acc[ai][0][m][1] + b1;
#pragma unroll
                    for (int j = 0; j < 4; ++j) { v0[j] = v0[j] > 20.f ? v0[j] : log1pf(__expf(v0[j])); v1[j] = v1[j] > 20.f ? v1[j] : log1pf(__expf(v1[j])); }
                    *(f32x4*)(rowp) = v0; *(f32x4*)(rowp + 4) = v1; }
        }
    }
};
struct EpiBf16 {
    static constexpr bool PERM = true, PREFETCH = false, MIDSCALE = true;
    bf16_t* O; int ldc; const float* rr;
    __device__ __forceinline__ void operator()(const f32x4 (&acc)[2][2][4][2], const Unit& u, int wr, int wc, int fr, int fq, const LAS unsigned char*) const {
        const int row0 = u.arow0 + wr * 64 + fr, col0 = u.pn * BM + wc * 32 + 8 * fq;
#pragma unroll
        for (int ai = 0; ai < 2; ++ai)
#pragma unroll
            for (int m = 0; m < 4; ++m) { bf16_t* rowp = O + (size_t)(row0 + ai * HALF + m * 16) * ldc + col0;
#pragma unroll
                for (int bj = 0; bj < 2; ++bj) { const f32x4 v0 = acc[ai][bj][m][0], v1 = acc[ai][bj][m][1];
                    u32x4 w; w.x = cvt_pk_bf16(v0[0], v0[1]); w.y = cvt_pk_bf16(v0[2], v0[3]); w.z = cvt_pk_bf16(v1[0], v1[1]); w.w = cvt_pk_bf16(v1[2], v1[3]);
                    *(u32x4*)(rowp + bj * HALF) = w; } }
    }
};
struct EpiSwiglu {
    static constexpr bool PERM = true, PREFETCH = true, MIDSCALE = false;
    bf16_t* ACT; const float* b_gu;
    __device__ __forceinline__ void prefetch(const Unit& u, LAS unsigned char* pf, int wid, int lane) const {
        if (wid == 0) __builtin_amdgcn_global_load_lds((const unsigned*)(b_gu + (size_t)u.e * 2048 + (lane >> 5) * FF + u.pn * HALF + 4 * (lane & 31)), (LAS unsigned*)pf, 16, 0, 0);
    }
    __device__ __forceinline__ void operator()(const f32x4 (&acc)[2][2][4][2], const Unit& u, int wr, int wc, int fr, int fq, const LAS unsigned char* pf) const {
        const int row0 = u.arow0 + wr * 64 + fr, col0 = u.pn * HALF + wc * 32 + 8 * fq;
        const LAS float* bg = (const LAS float*)pf + wc * 32 + 8 * fq;
        f32x4 bgate[2], bup[2];
#pragma unroll
        for (int n = 0; n < 2; ++n) { bgate[n] = *(const LAS f32x4*)(bg + 4 * n); bup[n] = *(const LAS f32x4*)(bg + HALF + 4 * n); }
#pragma unroll
        for (int ai = 0; ai < 2; ++ai)
#pragma unroll
            for (int m = 0; m < 4; ++m) {
                float a[8];
#pragma unroll
                for (int n = 0; n < 2; ++n)
#pragma unroll
                    for (int j = 0; j < 4; ++j) {
                        const float gate = fminf(acc[ai][0][m][n][j] + bgate[n][j], 7.f), up = fminf(fmaxf(acc[ai][1][m][n][j] + bup[n][j], -7.f), 7.f);
                        a[4 * n + j] = (up + 1.f) * gate * __builtin_amdgcn_rcpf(1.f + __expf(-1.702f * gate));
                    }
                u32x4 w; w.x = cvt_pk_bf16(a[0], a[1]); w.y = cvt_pk_bf16(a[2], a[3]); w.z = cvt_pk_bf16(a[4], a[5]); w.w = cvt_pk_bf16(a[6], a[7]);
                *(u32x4*)(ACT + (size_t)(row0 + ai * HALF + m * 16) * FF + col0) = w;
            }
    }
};
struct EpiDown {
    static constexpr bool PERM = true, PREFETCH = true, MIDSCALE = false;
    bf16_t* Y; const float* b_dn; const int* sorted; const float* sortw;
    __device__ __forceinline__ void prefetch(const Unit& u, LAS unsigned char* pf, int wid, int lane) const {
        if (wid == 0) __builtin_amdgcn_global_load_lds((const unsigned*)(sorted + (size_t)u.e * TT + u.lrow0 + 4 * lane), (LAS unsigned*)pf, 16, 0, 0);
        else if (wid == 1) __builtin_amdgcn_global_load_lds((const unsigned*)(sortw + (size_t)u.e * TT + u.lrow0 + 4 * lane), (LAS unsigned*)(pf + 1024), 16, 0, 0);
        else if (wid == 2) __builtin_amdgcn_global_load_lds((const unsigned*)(b_dn + (size_t)u.e * DM + u.pn * BM + 4 * lane), (LAS unsigned*)(pf + 2048), 16, 0, 0);
    }
    __device__ __forceinline__ void operator()(const f32x4 (&acc)[2][2][4][2], const Unit& u, int wr, int wc, int fr, int fq, const LAS unsigned char* pf) const {
        const int col0 = u.pn * BM + wc * 32 + 8 * fq;
        const LAS float* bp = (const LAS float*)(pf + 2048) + wc * 32 + 8 * fq;
        f32x4 bv[2][2];
#pragma unroll
        for (int bj = 0; bj < 2; ++bj)
#pragma unroll
            for (int n = 0; n < 2; ++n) bv[bj][n] = *(const LAS f32x4*)(bp + bj * HALF + 4 * n);
        int slot[8]; float wgt[8];
#pragma unroll
        for (int q = 0; q < 8; ++q) { const int r = (q >> 2) * HALF + wr * 64 + (q & 3) * 16 + fr; slot[q] = ((const LAS int*)pf)[r]; wgt[q] = ((const LAS float*)(pf + 1024))[r]; }
#pragma unroll
        for (int ai = 0; ai < 2; ++ai)
#pragma unroll
            for (int m = 0; m < 4; ++m) {
                const int r = ai * HALF + wr * 64 + m * 16 + fr;
                if (r < u.nvalid) {
                    const float w = wgt[ai * 4 + m];
                    bf16_t* rowp = Y + (size_t)slot[ai * 4 + m] * DM + col0;
#pragma unroll
                    for (int bj = 0; bj < 2; ++bj) { const f32x4 v0 = (acc[ai][bj][m][0] + bv[bj][0]) * w, v1 = (acc[ai][bj][m][1] + bv[bj][1]) * w;
                        u32x4 o; o.x = cvt_pk_bf16(v0[0], v0[1]); o.y = cvt_pk_bf16(v0[2], v0[3]); o.z = cvt_pk_bf16(v1[0], v1[1]); o.w = cvt_pk_bf16(v1[2], v1[3]);
                        *(u32x4*)(rowp + bj * HALF) = o; }
                }
            }
    }
};

template <class Epi, class Sched, bool ALIGN_EPI>
__device__ __forceinline__ void gemm_phase(LAS unsigned char* lds, const Gemm g, const Sched& S, const Epi& E, int wid) {
    const int lane = lane_id_fresh(), tid = wid * 64 + lane, wr = wid >> 2, wc = wid & 3, fr = lane & 15, fq = lane >> 4;
    const int K = g.K, nt = K / BK;
    int RA[2], CA[2]; unsigned voffB[2];
#pragma unroll
    for (int i = 0; i < 2; ++i) { int R, C; stage_rc(tid * 16 + i * 8192, R, C); const int Rb = Epi::PERM ? ((R & ~31) + perm32(R & 31)) : R;
        RA[i] = R; CA[i] = C; voffB[i] = (unsigned)(Rb * K + C) * 2u; }
    const size_t kstep = (size_t)(BK * 2);
    const size_t hstep = (size_t)HALF * K * 2;
    const unsigned ldsw = (unsigned)wid * 1024u;
    const int aoff = lds_byte(wr * 64 + fr, fq * 8), boff = lds_byte(wc * 32 + fr, fq * 8);
#define PG8_SA(b, h) (((b) * 2 + (h)) * HTB)
#define PG8_SB(b, h) ((4 + (b) * 2 + (h)) * HTB)
#define PG8_STAGE(bufoff, gbase, voff) do { _Pragma("unroll") for (int _i = 0; _i < 2; ++_i) \
        __builtin_amdgcn_global_load_lds((const unsigned*)((const char*)(gbase) + (voff)[_i]), (LAS unsigned*)(lds + (bufoff) + ldsw + _i * 8192), 16, 0, 0); } while (0)
#define PG8_LDA(dst, b, h) do { _Pragma("unroll") for (int m = 0; m < 4; ++m) _Pragma("unroll") for (int k = 0; k < 2; ++k) dst[m][k] = *(const LAS bf16x8*)(lds + PG8_SA(b, h) + aoff + m * 2048 + k * 1024); } while (0)
#define PG8_LDB(dst, b, h) do { _Pragma("unroll") for (int n = 0; n < 2; ++n) _Pragma("unroll") for (int k = 0; k < 2; ++k) dst[n][k] = *(const LAS bf16x8*)(lds + PG8_SB(b, h) + boff + n * 2048 + k * 1024); } while (0)
#define PG8_MMA(ai, bj, At, Bt) do { __builtin_amdgcn_s_setprio(1); _Pragma("unroll") for (int m = 0; m < 4; ++m) _Pragma("unroll") for (int n = 0; n < 2; ++n) _Pragma("unroll") for (int k = 0; k < 2; ++k) \
        acc[ai][bj][m][n] = __builtin_amdgcn_mfma_f32_16x16x32_bf16(Bt[n][k], At[m][k], acc[ai][bj][m][n], 0, 0, 0); __builtin_amdgcn_s_setprio(0); } while (0)
#define PG8_WAIT_V(n) asm volatile("s_waitcnt vmcnt(" #n ")" ::: "memory")
#define PG8_WAIT_L(n) asm volatile("s_waitcnt lgkmcnt(" #n ")" ::: "memory")
#define PG8_BAR __builtin_amdgcn_s_barrier()
#define PG8_SCHED __builtin_amdgcn_sched_barrier(0)
    Unit cur, nxt; int ui = 0;
    if (!S.next(0, cur)) return;
    f32x4 acc[2][2][4][2];
#pragma unroll
    for (int a = 0; a < 2; ++a)
#pragma unroll
        for (int b = 0; b < 2; ++b)
#pragma unroll
            for (int m = 0; m < 4; ++m)
#pragma unroll
                for (int n = 0; n < 2; ++n) acc[a][b][m][n] = (f32x4){0.f, 0.f, 0.f, 0.f};
    bf16x8 At[4][2], B0[2][2], B1[2][2];
    unsigned coffA[2][2], noffA[2][2];
    S.a_off(cur, RA, CA, coffA);
    if constexpr (Epi::PREFETCH) E.prefetch(cur, lds + PF_OFF, wid, lane);
    const char* gA = (const char*)g.A; const char* cB = (const char*)g.Bt + cur.boff;
    PG8_STAGE(PG8_SB(0, 0), cB, voffB); PG8_STAGE(PG8_SB(0, 1), cB + hstep, voffB); PG8_STAGE(PG8_SA(0, 0), gA, coffA[0]); PG8_STAGE(PG8_SA(0, 1), gA, coffA[1]);
    if (wr == 1) PG8_BAR;
    PG8_WAIT_V(2); PG8_BAR;
    PG8_STAGE(PG8_SB(1, 0), cB + kstep, voffB); PG8_STAGE(PG8_SA(1, 0), gA + kstep, coffA[0]); PG8_STAGE(PG8_SB(1, 1), cB + hstep + kstep, voffB);
    PG8_WAIT_V(6); PG8_BAR;
    for (;;) {
        const bool has_next = S.next(ui + 1, nxt);
        if (has_next) S.a_off(nxt, RA, CA, noffA);
        else {
#pragma unroll
            for (int h = 0; h < 2; ++h)
#pragma unroll
                for (int i = 0; i < 2; ++i) noffA[h][i] = coffA[h][i];
        }
        const char* nB = has_next ? (const char*)g.Bt + nxt.boff : cB;
        for (int t = 0; t < nt; t += 2) {
            const bool last = (t == nt - 2);
            if constexpr (Epi::MIDSCALE) {
                if (t == nt / 2) {
                    int frx = fr; asm volatile("" : "+v"(frx));
                    const float* rb = E.rr + __builtin_amdgcn_readfirstlane(cur.arow0) + wr * 64 + frx;
#pragma unroll
                    for (int a = 0; a < 2; ++a)
#pragma unroll
                        for (int m = 0; m < 4; ++m) { const float rv = rsqrtf((rb[a * HALF + m * 16] + rb[TT + a * HALF + m * 16]) * (1.f / DM) + RMS_EPS);
#pragma unroll
                            for (int b = 0; b < 2; ++b)
#pragma unroll
                                for (int n = 0; n < 2; ++n) acc[a][b][m][n] = acc[a][b][m][n] * rv; }
                }
            }
            const char* a1 = gA + (size_t)(t + 1) * kstep;
            const char* a2 = last ? gA : gA + (size_t)(t + 2) * kstep; const char* b2 = last ? nB : cB + (size_t)(t + 2) * kstep;
            const char* a3 = a2 + kstep; const char* b3 = b2 + kstep;
            unsigned o2[2][2];
#pragma unroll
            for (int h = 0; h < 2; ++h)
#pragma unroll
                for (int i = 0; i < 2; ++i) o2[h][i] = last ? noffA[h][i] : coffA[h][i];
            PG8_LDB(B0, 0, 0); PG8_LDB(B1, 0, 1); PG8_SCHED; PG8_LDA(At, 0, 0); PG8_STAGE(PG8_SA(1, 1), a1, coffA[1]);
            PG8_WAIT_V(8); PG8_WAIT_L(0); PG8_BAR; PG8_MMA(0, 0, At, B0); PG8_MMA(0, 1, At, B1); PG8_BAR; PG8_SCHED;
            PG8_LDA(At, 0, 1); PG8_STAGE(PG8_SB(0, 0), b2, voffB); PG8_STAGE(PG8_SB(0, 1), b2 + hstep, voffB); PG8_STAGE(PG8_SA(0, 0), a2, o2[0]);
            PG8_WAIT_V(8); PG8_WAIT_L(0); PG8_BAR; PG8_MMA(1, 0, At, B0); PG8_MMA(1, 1, At, B1); PG8_BAR; PG8_SCHED;
            PG8_LDB(B0, 1, 0); PG8_LDB(B1, 1, 1); PG8_SCHED; PG8_LDA(At, 1, 0); PG8_STAGE(PG8_SA(0, 1), a2, o2[1]);
            PG8_WAIT_V(8); PG8_WAIT_L(0); PG8_BAR; PG8_MMA(0, 0, At, B0); PG8_MMA(0, 1, At, B1); PG8_BAR; PG8_SCHED;
            PG8_LDA(At, 1, 1); PG8_STAGE(PG8_SB(1, 0), b3, voffB); PG8_STAGE(PG8_SB(1, 1), b3 + hstep, voffB); PG8_STAGE(PG8_SA(1, 0), a3, o2[0]);
            PG8_WAIT_V(8); PG8_WAIT_L(0); PG8_BAR; PG8_MMA(1, 0, At, B0); PG8_MMA(1, 1, At, B1); PG8_BAR; PG8_SCHED;
        }
        if constexpr (ALIGN_EPI) { if (wr == 0) PG8_BAR; }
        if constexpr (Epi::PREFETCH) { if (has_next) E.prefetch(nxt, lds + PF_OFF + ((ui + 1) & 1) * PF_BYTES, wid, lane); }
        E(acc, cur, wr, wc, fr, fq, lds + PF_OFF + (ui & 1) * PF_BYTES);
        if (!has_next) break;
#pragma unroll
        for (int a = 0; a < 2; ++a)
#pragma unroll
            for (int b = 0; b < 2; ++b)
#pragma unroll
                for (int m = 0; m < 4; ++m)
#pragma unroll
                    for (int n = 0; n < 2; ++n) acc[a][b][m][n] = (f32x4){0.f, 0.f, 0.f, 0.f};
        cur = nxt; cB = nB; ++ui;
#pragma unroll
        for (int h = 0; h < 2; ++h)
#pragma unroll
            for (int i = 0; i < 2; ++i) coffA[h][i] = noffA[h][i];
        if constexpr (ALIGN_EPI) { if (wr == 1) PG8_BAR; }
    }
    PG8_WAIT_V(0);
    if constexpr (!ALIGN_EPI) { if (wr == 0) PG8_BAR; }
    PG8_BAR;
#undef PG8_SA
#undef PG8_SB
#undef PG8_STAGE
#undef PG8_LDA
#undef PG8_LDB
#undef PG8_MMA
#undef PG8_WAIT_V
#undef PG8_WAIT_L
#undef PG8_BAR
#undef PG8_SCHED
}
}

#define XB_TMO      128
#define XB_XCNT(j)  (256  + 64 * (j))
#define XB_XSUB(j)  (1280 + 64 * (j))
#define XB_XGEN(j)  (2304 + 64 * (j))
#define XB_TOP      3328
#define XB_TOPGEN   3392
#define XCD_BAR_WORDS 3456
#define XB_SPIN_CAP (1u << 18)
__device__ __forceinline__ unsigned xb_ld(unsigned* p)              { return __hip_atomic_load(p, __ATOMIC_RELAXED, __HIP_MEMORY_SCOPE_AGENT); }
__device__ __forceinline__ unsigned xb_add(unsigned* p, unsigned v) { return __hip_atomic_fetch_add(p, v, __ATOMIC_RELAXED, __HIP_MEMORY_SCOPE_AGENT); }
__device__ __forceinline__ unsigned xb_xcc_id() { return (unsigned)__builtin_amdgcn_s_getreg((3 << 11) | 20) & 0xFu; }
#define XB_SPIN(cond, bar) do { unsigned _sp = 0; while (cond) { __builtin_amdgcn_s_sleep(1); \
    if ((++_sp & 255u) == 0u) { if (xb_ld(&(bar)[XB_TMO])) break; if (_sp > XB_SPIN_CAP) { atomicAdd(&(bar)[XB_TMO], 1u); break; } } } } while (0)
struct XcdBarrier { unsigned* bar; unsigned x; volatile LAS unsigned* st; };
__device__ __forceinline__ XcdBarrier xcd_barrier_post(unsigned* bar, volatile LAS unsigned* st) {
    XcdBarrier b; b.bar = bar; b.x = xb_xcc_id(); b.st = st;
    if (threadIdx.x == 0) (void)xb_add(&bar[XB_XCNT(b.x)], 1u);
    return b;
}
__device__ __forceinline__ void xcd_barrier_complete(unsigned* bar, unsigned x, unsigned& nloc, unsigned& nx) {
    const unsigned G = gridDim.x * gridDim.y * gridDim.z;
    unsigned sum, cnt, mine, sp = 0u;
    for (;;) {
        sum = 0u; cnt = 0u; mine = 0u;
#pragma unroll
        for (unsigned j = 0; j < 16; ++j) { const unsigned c = xb_ld(&bar[XB_XCNT(j)]); sum += c; cnt += (c > 0u) ? 1u : 0u; mine = (j == x) ? c : mine; }
        if (sum == G) break;
        __builtin_amdgcn_s_sleep(1);
        if ((++sp & 255u) == 0u) { if (xb_ld(&bar[XB_TMO])) break; if (sp > XB_SPIN_CAP) { atomicAdd(&bar[XB_TMO], 1u); break; } }
    }
    nloc = mine > 0u ? mine : 1u; nx = cnt > 0u ? cnt : 1u;
}
__device__ __forceinline__ void xcd_barrier(const XcdBarrier& b, int wave) {
    asm volatile("s_waitcnt vmcnt(0)" ::: "memory");
    __syncthreads();
    if (wave == 0 && lane_id_fresh() == 0) {
        unsigned* bar = b.bar;
        __builtin_amdgcn_s_waitcnt(0);
        unsigned nloc = b.st[0], nx = b.st[1];
        if (nloc == 0u) { xcd_barrier_complete(bar, b.x, nloc, nx); b.st[0] = nloc; b.st[1] = nx; }
        const unsigned old = xb_add(&bar[XB_XSUB(b.x)], 1u);
        const unsigned gen = old / nloc;
        if (old + 1u == (gen + 1u) * nloc) {
            __builtin_amdgcn_fence(__ATOMIC_RELEASE, "agent");
            asm volatile("s_waitcnt vmcnt(0)" ::: "memory");
            const unsigned og = xb_add(&bar[XB_TOP], 1u);
            const unsigned tg = og / nx;
            if (og + 1u == (tg + 1u) * nx) xb_add(&bar[XB_TOPGEN], 1u);
            else XB_SPIN(xb_ld(&bar[XB_TOPGEN]) == tg, bar);
            __builtin_amdgcn_fence(__ATOMIC_ACQUIRE, "agent");
            xb_add(&bar[XB_XGEN(b.x)], 1u);
            asm volatile("s_waitcnt vmcnt(0)" ::: "memory");
        } else {
            XB_SPIN(xb_ld(&bar[XB_XGEN(b.x)]) == gen, bar);
            __builtin_amdgcn_fence(__ATOMIC_ACQUIRE, "agent");
            asm volatile("s_waitcnt vmcnt(0)" ::: "memory");
        }
    }
    __syncthreads();
}

struct Ctx {
    LAS unsigned char* lds; int wave, G, bid;
    const float *x, *c, *w_ada, *b_ada, *g_pre_mix, *g_post_mix, *w_in, *conv_w, *conv_b, *dt_bias, *a_log, *d_skip, *g_ssd, *w_out, *g_pre_ffn, *g_post_ffn, *w_router, *b_router, *w_gu, *b_gu, *w_dn, *b_dn;
    float* out; unsigned* ctl; float* mod;
    bf16_t *WIN, *WOUT, *WGU, *WDN, *H, *PROJ, *XC, *MIXIN, *ACT, *YSLOT;
    float *DT, *TOPW, *CUM, *CHDEC, *LSE, *SORTW, *RR; int* SORT; bf16_t *STATES, *OPART, *HPREV, *WRT, *MIX, *RES;
};

struct P0Item { const float* src; bf16_t* dst; int N, K, gu; };
__device__ __forceinline__ void p0_load(const P0Item& d, int lane, f32x4 (&v)[8]) {
    const float* p = d.src + (size_t)(lane >> 3) * d.N + 4 * (lane & 7);
#pragma unroll
    for (int j = 0; j < 8; ++j) v[j] = *(const f32x4*)(p + (size_t)(8 * j) * d.N);
}
__device__ __forceinline__ void p0_emit(const P0Item& d, int n0, int lane, LAS float* scr, const f32x4 (&v)[8]) {
    LAS float* w = scr + (lane >> 3) * 33 + 4 * (lane & 7);
#pragma unroll
    for (int j = 0; j < 8; ++j) { w[(8 * j) * 33] = v[j].x; w[(8 * j) * 33 + 1] = v[j].y; w[(8 * j) * 33 + 2] = v[j].z; w[(8 * j) * 33 + 3] = v[j].w; }
    LDS_WAIT(); asm volatile("" ::: "memory");
    const int c = lane & 7;
#pragma unroll
    for (int j = 0; j < 4; ++j) { const int n = (lane >> 3) + 8 * j; const LAS float* s = scr + (8 * c) * 33 + n;
        u32x4 o; o.x = pk2(s[0 * 33], s[1 * 33]); o.y = pk2(s[2 * 33], s[3 * 33]); o.z = pk2(s[4 * 33], s[5 * 33]); o.w = pk2(s[6 * 33], s[7 * 33]);
        int row = n;
        if (d.gu) { const int g = n0 + n, jj = g < FF ? g : g - FF; row = (jj >> 7) * 256 + (g < FF ? 0 : 128) + (jj & 127) - n0; }
        *(GAS u32x4*)(d.dst + (ptrdiff_t)row * d.K + 8 * c) = o; }
    LDS_WAIT(); asm volatile("" ::: "memory");
}

__device__ __forceinline__ void p0_prologue(const Ctx& F) {
    const int f_lane = lane_id_fresh();
    {
        LAS float* red = (LAS float*)(F.lds);
        for (int it = F.bid; it < 96; it += F.G) {
            const int col = it * 64 + f_lane; float a0 = 0.f, a1 = 0.f;
#pragma unroll 16
            for (int k = F.wave * 128; k < F.wave * 128 + 128; ++k) { const float w = F.w_ada[(size_t)k * 6144 + col]; a0 += siluf(F.c[k]) * w; a1 += siluf(F.c[DM + k]) * w; }
            red[(F.wave * 2 + 0) * 64 + f_lane] = a0; red[(F.wave * 2 + 1) * 64 + f_lane] = a1;
            __syncthreads();
            if (F.wave < 2) { float s = F.b_ada[col];
#pragma unroll
                for (int w = 0; w < 8; ++w) s += red[(w * 2 + F.wave) * 64 + f_lane];
                F.mod[F.wave * 6144 + col] = s; }
            asm volatile("s_waitcnt vmcnt(0)" ::: "memory");
            __syncthreads();
            if (F.wave == 0 && f_lane == 0) {
                __builtin_amdgcn_fence(__ATOMIC_RELEASE, "agent"); asm volatile("s_waitcnt vmcnt(0)" ::: "memory");
                __hip_atomic_fetch_add(F.ctl + CW_MODCNT, 1u, __ATOMIC_RELAXED, __HIP_MEMORY_SCOPE_AGENT); }
        }
    }
    for (int i = F.bid * NTHREADS + F.wave * 64 + f_lane; i < DM * NEXP; i += F.G * NTHREADS) { const int k = i >> 5, e = i & 31; const float w = F.w_router[i];
        const bf16_t hi = f2bf(w); F.WRT[e * DM + k] = hi; F.WRT[NEXP * DM + e * DM + k] = f2bf(w - bf2f(hi)); }
    LAS float* scr = (LAS float*)(F.lds + F.wave * 16384);
    const int gw = F.bid * NWAVES + F.wave, NGW = F.G * NWAVES;
    constexpr int I_IN = (DM / 64) * (NPROJ_ALL / 32), I_OUT = (2048 / 64) * (DM / 32);
    constexpr int NITEMS = I_IN; (void)I_OUT;
    auto desc = [&](int it, P0Item& d, int& n0) {
        int r = it; const float* W; bf16_t* WT; int K, N; d.gu = 0;
        if (r < I_IN) { W = F.w_in; WT = F.WIN; K = DM; N = NPROJ_ALL; }
        else { r -= I_IN; W = F.w_out; WT = F.WOUT; K = 2048; N = DM; }
        const int nblk = N / 32, kb = r / nblk, nb = r - kb * nblk; n0 = 32 * nb;
        const int kd = (W == F.w_out) ? ((kb + 16) & 31) : kb;
        d.src = W + (size_t)(64 * kb) * N + n0; d.dst = WT + (size_t)n0 * K + 64 * kd; d.N = N; d.K = K;
    };
    f32x4 va[8]; P0Item da; int na = 0;
    for (int it = gw; it < NITEMS; it += NGW) { desc(it, da, na); p0_load(da, f_lane, va); p0_emit(da, na, f_lane, scr, va); }
}

constexpr int FI_OUT = (2048 / 64) * (DM / 32), FI_GU = (DM / 64) * (2048 / 32), FI_DN = (FF / 64) * (DM / 32), FILL_OUT = FI_OUT, FILL_GU = FILL_OUT + NEXP * FI_GU, FILL_ALL = FILL_GU + NEXP * FI_DN;
__device__ __forceinline__ void merge_token(const Ctx& F, int t, int lane) {
    const int hd = lane >> 2;
    const float l0 = F.LSE[(size_t)t * 16 + hd], l1 = F.LSE[((size_t)TT + t) * 16 + hd], l2 = F.LSE[((size_t)2 * TT + t) * 16 + hd];
    u32x4 v[3][2];
#pragma unroll
    for (int g = 0; g < 3; ++g) { const bf16_t* src = F.OPART + ((size_t)g * TT + t) * DM + 16 * lane; v[g][0] = *(const u32x4*)src; v[g][1] = *(const u32x4*)(src + 8); }
    const float m = fmaxf(l0, fmaxf(l1, l2)), e0 = __builtin_amdgcn_exp2f(l0 - m), e1 = __builtin_amdgcn_exp2f(l1 - m), e2 = __builtin_amdgcn_exp2f(l2 - m), inv = 1.f / (e0 + e1 + e2);
    const float w[3] = {e0 * inv, e1 * inv, e2 * inv};
#pragma unroll
    for (int hv = 0; hv < 2; ++hv) { float a[8] = {0.f, 0.f, 0.f, 0.f, 0.f, 0.f, 0.f, 0.f};
#pragma unroll
        for (int g = 0; g < 3; ++g) { const u32x4 q = v[g][hv];
            a[0] += w[g] * __uint_as_float(q.x << 16); a[1] += w[g] * __uint_as_float(q.x & 0xffff0000u); a[2] += w[g] * __uint_as_float(q.y << 16); a[3] += w[g] * __uint_as_float(q.y & 0xffff0000u);
            a[4] += w[g] * __uint_as_float(q.z << 16); a[5] += w[g] * __uint_as_float(q.z & 0xffff0000u); a[6] += w[g] * __uint_as_float(q.w << 16); a[7] += w[g] * __uint_as_float(q.w & 0xffff0000u); }
        u32x4 o; o.x = pk2(a[0], a[1]); o.y = pk2(a[2], a[3]); o.z = pk2(a[4], a[5]); o.w = pk2(a[6], a[7]);
        *(u32x4*)(F.MIXIN + (size_t)t * 2048 + 1024 + 16 * lane + 8 * hv) = o; }
}
constexpr int FQ_OUT = FILL_OUT / NWAVES, FQ_GU = FILL_GU / NWAVES, FQ_ALL = FILL_ALL / NWAVES, MQ_ALL = TT / (2 * NWAVES);
struct Fill { int pend, mpend, mopen, wdone, mdone; };
__device__ __forceinline__ void merge_item(const Ctx& F, int it) {
    const int lane = lane_id_fresh(), t = (it * NWAVES + F.wave) * 2;
    merge_token(F, t, lane); merge_token(F, t + 1, lane);
}
__device__ __forceinline__ void fill_item(const Ctx& F, int it) {
    const int lane = lane_id_fresh(); int r = it * NWAVES + F.wave;
    P0Item d; const float* W; bf16_t* WT; int K, N; int kswap = 0;
    if (r < FILL_OUT) { W = F.w_out; WT = F.WOUT; K = 2048; N = DM; d.gu = 0; kswap = 16; }
    else if (r < FILL_GU) { r -= FILL_OUT; const int e = r / FI_GU; r -= e * FI_GU; W = F.w_gu + (size_t)e * DM * 2048; WT = F.WGU + (size_t)e * 2048 * DM; K = DM; N = 2048; d.gu = 1; }
    else { r -= FILL_GU; const int e = r / FI_DN; r -= e * FI_DN; W = F.w_dn + (size_t)e * FF * DM; WT = F.WDN + (size_t)e * DM * FF; K = FF; N = DM; d.gu = 0; }
    const int nblk = N / 32, kb = r / nblk, nb = r - kb * nblk, n0 = 32 * nb;
    d.src = W + (size_t)(64 * kb) * N + n0; d.dst = WT + (size_t)n0 * K + 64 * (kswap ? ((kb + kswap) & 31) : kb); d.N = N; d.K = K;
    f32x4 v[8]; p0_load(d, lane, v); p0_emit(d, n0, lane, (LAS float*)(F.lds + F.wave * 16384), v);
}
__device__ __forceinline__ int fill_want(const Fill& fs) { if (fs.pend >= 0 || fs.mpend >= 0) return 0; if (fs.mopen && !fs.mdone) return 2; return fs.wdone ? 0 : 1; }
__device__ __forceinline__ void fill_take(Fill& fs, int want, int v) {
    if (want == 2) { if (v >= MQ_ALL) fs.mdone = 1; else fs.mpend = v; } else if (want == 1) { if (v >= FQ_ALL) fs.wdone = 1; else fs.pend = v; }
}
__device__ __forceinline__ void fill_drain(const Ctx& F, Fill& fs, int which, int limit, volatile LAS unsigned* W) {
    const bool t0 = (F.wave == 0 && lane_id_fresh() == 0);
    for (;;) {
        if (which == 2) { if (fs.mpend >= 0) { merge_item(F, fs.mpend); fs.mpend = -1; } if (fs.mdone) break; }
        else { if (fs.pend >= 0) { if (fs.pend >= limit) break; fill_item(F, fs.pend); fs.pend = -1; } if (fs.wdone) break; }
        __syncthreads();
        if (t0) W[5] = (unsigned)__hip_atomic_fetch_add(F.ctl + (which == 2 ? CW_MQ : CW_FQ), 1u, __ATOMIC_RELAXED, __HIP_MEMORY_SCOPE_AGENT);
        __syncthreads();
        fill_take(fs, which, (int)W[5]);
    }
}
__device__ __forceinline__ void xcd_barrier_fill(const XcdBarrier& b, const Ctx& F, Fill& fs) {
    asm volatile("s_waitcnt vmcnt(0)" ::: "memory");
    __syncthreads();
    const bool t0 = (F.wave == 0 && lane_id_fresh() == 0);
    volatile LAS unsigned* W = b.st;
    unsigned* bar = b.bar;
    if (t0) {
        __builtin_amdgcn_s_waitcnt(0);
        unsigned nloc = W[0], nx = W[1];
        if (nloc == 0u) { xcd_barrier_complete(bar, b.x, nloc, nx); W[0] = nloc; W[1] = nx; }
        const unsigned old = xb_add(&bar[XB_XSUB(b.x)], 1u), gen = old / nloc;
        unsigned role = 0u, val = gen;
        if (old + 1u == (gen + 1u) * nloc) {
            __builtin_amdgcn_fence(__ATOMIC_RELEASE, "agent");
            asm volatile("s_waitcnt vmcnt(0)" ::: "memory");
            const unsigned og = xb_add(&bar[XB_TOP], 1u), tg = og / nx;
            role = 1u; val = tg;
            if (og + 1u == (tg + 1u) * nx) { xb_add(&bar[XB_TOPGEN], 1u); role = 3u; }
        }
        W[2] = role; W[3] = val; W[4] = 0u;
    }
    for (unsigned it = 0;; ++it) {
        __syncthreads();
        if (t0) {
            const unsigned role = W[2], val = W[3]; bool done;
            const int want = fill_want(fs);
            if (want) W[5] = (unsigned)__hip_atomic_fetch_add(F.ctl + (want == 2 ? CW_MQ : CW_FQ), 1u, __ATOMIC_RELAXED, __HIP_MEMORY_SCOPE_AGENT);
            if (role & 1u) done = (role & 2u) || (xb_ld(&bar[XB_TOPGEN]) != val); else done = (xb_ld(&bar[XB_XGEN(b.x)]) != val);
            if (!done && (it & 15u) == 15u) { if (xb_ld(&bar[XB_TMO])) done = true; else if (it > (1u << 16)) { atomicAdd(&bar[XB_TMO], 1u); done = true; } }
            if (done) { __builtin_amdgcn_fence(__ATOMIC_ACQUIRE, "agent"); if (role & 1u) xb_add(&bar[XB_XGEN(b.x)], 1u); }
            W[4] = done ? 1u : 0u;
        }
        __syncthreads();
        { const int want = fill_want(fs); if (want) fill_take(fs, want, (int)W[5]); }
        if (W[4]) break;
        if (fs.mpend >= 0) { merge_item(F, fs.mpend); fs.mpend = -1; } else if (fs.pend >= 0) { fill_item(F, fs.pend); fs.pend = -1; } else __builtin_amdgcn_s_sleep(4);
    }
    if (t0) asm volatile("s_waitcnt vmcnt(0)" ::: "memory");
    __syncthreads();
}

__device__ __forceinline__ void p1_prenorm(const Ctx& F) {
    const int gw = F.bid * NWAVES + F.wave, NGW = F.G * NWAVES, lane = lane_id_fresh();
    if (F.wave == 0 && lane == 0) {
        const unsigned need = (unsigned)min(96, F.G > 96 ? 96 : 96);
        unsigned sp = 0; while (__hip_atomic_load(F.ctl + CW_MODCNT, __ATOMIC_RELAXED, __HIP_MEMORY_SCOPE_AGENT) < need) { __builtin_amdgcn_s_sleep(2); if (++sp > (1u << 20)) break; }
        __builtin_amdgcn_fence(__ATOMIC_ACQUIRE, "agent"); asm volatile("s_waitcnt vmcnt(0)" ::: "memory"); }
    __syncthreads();
    f32x4 vn[2][4];
#define P1_LOAD(t0_) do { const int ta_ = (t0_), tb_ = (t0_) + NGW < TT ? (t0_) + NGW : (t0_); _Pragma("unroll") for (int j = 0; j < 4; ++j) { \
        vn[0][j] = *(const f32x4*)(F.x + (size_t)ta_ * DM + 4 * lane + 256 * j); vn[1][j] = *(const f32x4*)(F.x + (size_t)tb_ * DM + 4 * lane + 256 * j); } } while (0)
    if (gw < TT) P1_LOAD(gw);
    for (int t0 = gw; t0 < TT; t0 += 2 * NGW) {
        const int tt[2] = {t0, t0 + NGW < TT ? t0 + NGW : t0};
        f32x4 v[2][4]; float ss[2] = {0.f, 0.f};
#pragma unroll
        for (int q = 0; q < 2; ++q)
#pragma unroll
            for (int j = 0; j < 4; ++j) v[q][j] = vn[q][j];
        f32x4 ga[2][4], sh[2][4];
#pragma unroll
        for (int q = 0; q < 2; ++q) { const float* shift = F.mod + (tt[q] / SEQ) * 6144; const float* scale = shift + 1024;
#pragma unroll
            for (int j = 0; j < 4; ++j) { const int k = 4 * lane + 256 * j; if (q == 0 || tt[1] / SEQ != tt[0] / SEQ) { ga[q][j] = *(const f32x4*)(F.g_pre_mix + k) * (*(const f32x4*)(scale + k) + 1.f); sh[q][j] = *(const f32x4*)(shift + k); } else { ga[q][j] = ga[0][j]; sh[q][j] = sh[0][j]; } } }
        if (t0 + 2 * NGW < TT) P1_LOAD(t0 + 2 * NGW);
#pragma unroll
        for (int q = 0; q < 2; ++q)
#pragma unroll
            for (int j = 0; j < 4; ++j) ss[q] += v[q][j].x * v[q][j].x + v[q][j].y * v[q][j].y + v[q][j].z * v[q][j].z + v[q][j].w * v[q][j].w;
#pragma unroll
        for (int q = 0; q < 2; ++q) {
            const int t = tt[q];
            const float r = rsqrtf(wave_sum(ss[q]) * (1.f / DM) + RMS_EPS);
#pragma unroll
            for (int j = 0; j < 4; ++j) {
                const int k = 4 * lane + 256 * j;
                const f32x4 h = v[q][j] * r * ga[q][j] + sh[q][j];
                u32x2 o; o.x = pk2(h.x, h.y); o.y = pk2(h.z, h.w);
                *(u32x2*)(F.H + (size_t)t * DM + k) = o;
            }
        }
    }
#undef P1_LOAD
}
typedef short s16x4 __attribute__((ext_vector_type(4)));
typedef short v4i16_t __attribute__((ext_vector_type(4)));
__device__ __forceinline__ s16x4 tr_read(const LAS unsigned char* p) { return __builtin_bit_cast(s16x4, __builtin_amdgcn_ds_read_tr16_b64_v4i16((LAS v4i16_t*)p)); }
template <int OFF> __device__ __forceinline__ u32x2 tr_read_a(unsigned addr) { u32x2 r; asm volatile("ds_read_b64_tr_b16 %0, %1 offset:%2" : "=v"(r) : "v"(addr), "n"(OFF) : "memory"); return r; }
template <int OFF> __device__ __forceinline__ u32x4 lds_read_a(unsigned addr) { u32x4 r; asm volatile("ds_read_b128 %0, %1 offset:%2" : "=v"(r) : "v"(addr), "n"(OFF) : "memory"); return r; }
__device__ __forceinline__ void lds_wait4(u32x4 (&t)[4]) { asm volatile("s_waitcnt lgkmcnt(0)" : "+v"(t[0]), "+v"(t[1]), "+v"(t[2]), "+v"(t[3]) :: "memory"); }
__device__ __forceinline__ void tr_wait8(u32x2 (&t)[8]) { asm volatile("s_waitcnt lgkmcnt(0)" : "+v"(t[0]), "+v"(t[1]), "+v"(t[2]), "+v"(t[3]), "+v"(t[4]), "+v"(t[5]), "+v"(t[6]), "+v"(t[7]) :: "memory"); }
__device__ __forceinline__ bf16x8 cat8(s16x4 a, s16x4 b) { return (bf16x8){a[0], a[1], a[2], a[3], b[0], b[1], b[2], b[3]}; }
__device__ __forceinline__ unsigned cvtpk(float lo, float hi) { return pg8::cvt_pk_bf16(lo, hi); }
constexpr float LOG2E = 1.4426950408889634f;
__device__ __forceinline__ void p3_attention(const Ctx& F) {
    const int lane = lane_id_fresh(), wave = F.wave, tid = wave * 64 + lane, fr = lane & 15, fq = lane >> 4;
    LAS unsigned char* KIMG = F.lds;
    LAS unsigned char* VIMG = F.lds + 49152;
    const int vcu = (F.G % 8 == 0) ? (F.bid % 8) * (F.G / 8) + F.bid / 8 : F.bid;
    constexpr int NU = 2 * 16 * 3 * 32;
    const int per = (NU + F.G - 1) / F.G, u0 = vcu * per, u1 = min(NU, u0 + per);
    const int rsub = tid >> 3, c8 = tid & 7;
    LAS unsigned char* kst = KIMG + rsub * 128 + ((c8 ^ (rsub & 7)) << 4);
    LAS unsigned char* vst = VIMG + rsub * 128 + (((c8 >> 1) ^ ((rsub >> 1) & 3)) << 5) + (c8 & 1) * 16;
    u32x4 kr[6], vr[6]; bf16x8 qn_[2][2];
#define ATT_DECODE(u) const int bh_ = (u) / 96, rem_ = (u) % 96, g_ = rem_ >> 5, blk_ = rem_ & 31, sh_ = 2 * g_  , d_ = 1 << sh_, bpr_ = 32 >> sh_, \
        r_ = blk_ / bpr_, n0_ = (blk_ % bpr_) * 256, b_ = bh_ >> 4, h_ = bh_ & 15, Ls_ = SEQ >> sh_
#define ATT_LOAD_KV(u) do { ATT_DECODE(u); _Pragma("unroll") for (int i = 0; i < 6; ++i) { const int row = rsub + 64 * i, n = n0_ - 64 + row; \
            const bool ok = (n >= 0) && (n < Ls_); const bf16_t* src = F.PROJ + ((size_t)b_ * SEQ + (size_t)(ok ? n : 0) * d_ + r_) * NPROJ + h_ * 64 + c8 * 8; \
            kr[i] = ok ? *(const u32x4*)(src + C_K) : (u32x4){0u, 0u, 0u, 0u}; vr[i] = ok ? *(const u32x4*)(src + C_V) : (u32x4){0u, 0u, 0u, 0u}; } } while (0)
#define ATT_LOAD_Q(u) do { ATT_DECODE(u); _Pragma("unroll") for (int qt = 0; qt < 2; ++qt) { \
            const bf16_t* qp = F.PROJ + ((size_t)b_ * SEQ + (size_t)(n0_ + 32 * wave + 16 * qt + fr) * d_ + r_) * NPROJ + C_Q + h_ * 64 + 8 * fq; qn_[qt][0] = *(const bf16x8*)qp; qn_[qt][1] = *(const bf16x8*)(qp + 32); } } while (0)
    if (u0 < u1) { ATT_LOAD_KV(u0); } if (u0 < u1) { ATT_LOAD_Q(u0); }
    const int rq = (lane & 15) >> 2, cq = lane & 3, rl = 4 * fq + rq, xsw = (rl >> 1) & 3;
    const LAS unsigned char* vrow = VIMG + (32 * wave + rl) * 128 + cq * 8;
    const LAS unsigned char* krow = KIMG + (32 * wave + fr) * 128;
    const int jbase = 4 * fq - 64 - fr;
    float nb[9][4];
#pragma unroll
    for (int t = 0; t < 9; ++t)
#pragma unroll
        for (int i = 0; i < 4; ++i) { const int j = 16 * t + i + jbase, aj = j < 0 ? -j : j; nb[t][i] = (aj <= 64) ? -(float)aj : -1e30f; }
#pragma unroll 1
    for (int u = u0; u < u1; ++u) {
        __syncthreads();
#pragma unroll
        for (int i = 0; i < 6; ++i) { *(LAS u32x4*)(kst + i * 64 * 128) = kr[i]; *(LAS u32x4*)(vst + i * 64 * 128) = vr[i]; }
        __syncthreads();
        if (u + 1 < u1) ATT_LOAD_KV(u + 1);
        ATT_DECODE(u);
        const float slope2 = exp2f(-0.5f * (float)(h_ + 1)) * LOG2E * (float)d_;
        f32x4 s[2][9];
#pragma unroll
        for (int t = 0; t < 10; ++t) {
            bf16x8 kf[2];
#pragma unroll
            for (int ks = 0; ks < 2; ++ks) kf[ks] = *(const LAS bf16x8*)(krow + (16 * t) * 128 + (((4 * ks + fq) ^ (fr & 7)) << 4));
#pragma unroll
            for (int qt = 0; qt < 2; ++qt) { const int tp = t - qt; if (tp >= 0 && tp < 9) { f32x4 a = (f32x4){0.f, 0.f, 0.f, 0.f};
                a = __builtin_amdgcn_mfma_f32_16x16x32_bf16(kf[0], qn_[qt][0], a, 0, 0, 0); a = __builtin_amdgcn_mfma_f32_16x16x32_bf16(kf[1], qn_[qt][1], a, 0, 0, 0); s[qt][tp] = a; } }
        }
        if (u + 1 < u1) ATT_LOAD_Q(u + 1);
#pragma unroll
        for (int qt = 0; qt < 2; ++qt)
#pragma unroll
            for (int t = 0; t < 9; ++t)
#pragma unroll
                for (int i = 0; i < 4; ++i) s[qt][t][i] = s[qt][t][i] + slope2 * nb[t][i];
        if (n0_ == 0 || n0_ + 320 > Ls_) {
#pragma unroll
            for (int qt = 0; qt < 2; ++qt) { const int qn = n0_ + 32 * wave + 16 * qt + fr;
#pragma unroll
                for (int t = 0; t < 9; ++t)
#pragma unroll
                    for (int i = 0; i < 4; ++i) { const int j = 16 * t + i + jbase; if ((unsigned)(qn + j) >= (unsigned)Ls_) s[qt][t][i] = -1e30f; } }
        }
        float mx[2], lsum[2];
#pragma unroll
        for (int qt = 0; qt < 2; ++qt) { float m = -1e30f;
#pragma unroll
            for (int t = 0; t < 9; ++t) { asm("v_max3_f32 %0, %0, %1, %2" : "+v"(m) : "v"(s[qt][t][0]), "v"(s[qt][t][1])); asm("v_max3_f32 %0, %0, %1, %2" : "+v"(m) : "v"(s[qt][t][2]), "v"(s[qt][t][3])); }
            { const float m1 = __shfl_xor(m, 16); asm("v_max_f32 %0, %0, %1" : "+v"(m) : "v"(m1)); const float m2 = __shfl_xor(m, 32); asm("v_max_f32 %0, %0, %1" : "+v"(m) : "v"(m2)); } mx[qt] = m;
#pragma unroll
            for (int t = 0; t < 9; ++t)
#pragma unroll
                for (int i = 0; i < 4; ++i) s[qt][t][i] = __builtin_amdgcn_exp2f(s[qt][t][i] - m); }
        f32x4 o[2][4], osum[2];
        const bf16x8 ones = __builtin_bit_cast(bf16x8, (u32x4){0x3f803f80u, 0x3f803f80u, 0x3f803f80u, 0x3f803f80u});
#pragma unroll
        for (int qt = 0; qt < 2; ++qt) { osum[qt] = (f32x4){0.f, 0.f, 0.f, 0.f};
#pragma unroll
            for (int dt = 0; dt < 4; ++dt) o[qt][dt] = (f32x4){0.f, 0.f, 0.f, 0.f}; }
#pragma unroll
        for (int kk = 0; kk < 5; ++kk) {
            bf16x8 pop[2];
#pragma unroll
            for (int qt = 0; qt < 2; ++qt) { const int ta = 2 * kk - qt, tb = 2 * kk + 1 - qt; u32x4 pw = (u32x4){0u, 0u, 0u, 0u};
                if (ta >= 0 && ta < 9) { pw.x = cvtpk(s[qt][ta][0], s[qt][ta][1]); pw.y = cvtpk(s[qt][ta][2], s[qt][ta][3]); }
                if (tb >= 0 && tb < 9) { pw.z = cvtpk(s[qt][tb][0], s[qt][tb][1]); pw.w = cvtpk(s[qt][tb][2], s[qt][tb][3]); }
                pop[qt] = __builtin_bit_cast(bf16x8, pw); osum[qt] = __builtin_amdgcn_mfma_f32_16x16x32_bf16(ones, pop[qt], osum[qt], 0, 0, 0); }
#pragma unroll
            for (int dt = 0; dt < 4; ++dt) { const LAS unsigned char* vp = vrow + ((dt ^ xsw) << 5);
                const bf16x8 va = cat8(tr_read(vp + (32 * kk) * 128), tr_read(vp + (32 * kk + 16) * 128));
#pragma unroll
                for (int qt = 0; qt < 2; ++qt) o[qt][dt] = __builtin_amdgcn_mfma_f32_16x16x32_bf16(va, pop[qt], o[qt][dt], 0, 0, 0); }
        }
#pragma unroll
        for (int qt = 0; qt < 2; ++qt) {
            const int qn = n0_ + 32 * wave + 16 * qt + fr; const size_t tokq = (size_t)b_ * SEQ + (size_t)qn * d_ + r_;
            lsum[qt] = osum[qt][0];
            const float inv = __builtin_amdgcn_rcpf(lsum[qt]);
            bf16_t* op = F.OPART + ((size_t)g_ * TT + tokq) * DM + h_ * 64 + 4 * fq;
#pragma unroll
            for (int dt = 0; dt < 4; ++dt) { u32x2 w; w.x = cvtpk(o[qt][dt][0] * inv, o[qt][dt][1] * inv); w.y = cvtpk(o[qt][dt][2] * inv, o[qt][dt][3] * inv); *(u32x2*)(op + 16 * dt) = w; }
            if (fq == 0) F.LSE[((size_t)g_ * TT + tokq) * 16 + h_] = mx[qt] + log2f(lsum[qt]);
        }
    }
#undef ATT_LOAD_KV
#undef ATT_LOAD_Q
#undef ATT_DECODE
}
__device__ __forceinline__ void p4_attn_merge(const Ctx& F) {
    const int gw = F.bid * NWAVES + F.wave, NGW = F.G * NWAVES, lane = lane_id_fresh(), hd = lane >> 2;
#pragma unroll 2
    for (int t = gw; t < TT; t += NGW) {
        const float l0 = F.LSE[(size_t)t * 16 + hd], l1 = F.LSE[((size_t)TT + t) * 16 + hd], l2 = F.LSE[((size_t)2 * TT + t) * 16 + hd];
        const float m = fmaxf(l0, fmaxf(l1, l2)), e0 = exp2f(l0 - m), e1 = exp2f(l1 - m), e2 = exp2f(l2 - m), inv = 1.f / (e0 + e1 + e2);
        const float w[3] = {e0 * inv, e1 * inv, e2 * inv};
        float acc[16];
#pragma unroll
        for (int i = 0; i < 16; ++i) acc[i] = 0.f;
#pragma unroll
        for (int g = 0; g < 3; ++g) { const bf16_t* src = F.OPART + ((size_t)g * TT + t) * DM + 16 * lane;
#pragma unroll
            for (int hv = 0; hv < 2; ++hv) { const u32x4 v = *(const u32x4*)(src + 8 * hv);
                acc[8 * hv + 0] += w[g] * __uint_as_float(v.x << 16); acc[8 * hv + 1] += w[g] * __uint_as_float(v.x & 0xffff0000u); acc[8 * hv + 2] += w[g] * __uint_as_float(v.y << 16); acc[8 * hv + 3] += w[g] * __uint_as_float(v.y & 0xffff0000u);
                acc[8 * hv + 4] += w[g] * __uint_as_float(v.z << 16); acc[8 * hv + 5] += w[g] * __uint_as_float(v.z & 0xffff0000u); acc[8 * hv + 6] += w[g] * __uint_as_float(v.w << 16); acc[8 * hv + 7] += w[g] * __uint_as_float(v.w & 0xffff0000u); } }
#pragma unroll
        for (int hv = 0; hv < 2; ++hv) { u32x4 o; o.x = cvtpk(acc[8 * hv], acc[8 * hv + 1]); o.y = cvtpk(acc[8 * hv + 2], acc[8 * hv + 3]); o.z = cvtpk(acc[8 * hv + 4], acc[8 * hv + 5]); o.w = cvtpk(acc[8 * hv + 6], acc[8 * hv + 7]);
            *(u32x4*)(F.MIXIN + (size_t)t * 2048 + 1024 + 16 * lane + 8 * hv) = o; }
    }
}
__device__ __forceinline__ void p3_conv(const Ctx& F) {
    const int tid = F.wave * 64 + lane_id_fresh();
    if (tid >= 384) return;
    const int cg = tid % 192, half = tid / 192, c0 = cg * 8;
    float w[5][8], bias[8];
#pragma unroll
    for (int i = 0; i < 5; ++i) { const f32x4 a = *(const f32x4*)(F.conv_w + i * XBCW + c0), b = *(const f32x4*)(F.conv_w + i * XBCW + c0 + 4);
        w[i][0] = a.x; w[i][1] = a.y; w[i][2] = a.z; w[i][3] = a.w; w[i][4] = b.x; w[i][5] = b.y; w[i][6] = b.z; w[i][7] = b.w; }
    { const f32x4 a = *(const f32x4*)(F.conv_b + c0), b = *(const f32x4*)(F.conv_b + c0 + 4); bias[0] = a.x; bias[1] = a.y; bias[2] = a.z; bias[3] = a.w; bias[4] = b.x; bias[5] = b.y; bias[6] = b.z; bias[7] = b.w; }
    for (int u = F.bid; u < TT / 64; u += F.G) {
        const int tbase = u * 64 + half * 32, pos0 = tbase % SEQ;
        const bf16_t* src = F.PROJ + (size_t)tbase * NPROJ + C_XBC + c0;
        u32x4 rows[36];
#pragma unroll
        for (int i = 0; i < 36; ++i) { const int p = pos0 + i - 2; rows[i] = (p >= 0 && p < SEQ) ? *(const u32x4*)(src + (ptrdiff_t)(i - 2) * NPROJ) : (u32x4){0u, 0u, 0u, 0u}; }
#pragma unroll
        for (int t = 0; t < 32; ++t) {
            float acc[8];
#pragma unroll
            for (int k = 0; k < 8; ++k) acc[k] = bias[k];
#pragma unroll
            for (int i = 0; i < 5; ++i) { const u32x4 v = rows[t + i];
                acc[0] += __uint_as_float(v.x << 16) * w[i][0]; acc[1] += __uint_as_float(v.x & 0xffff0000u) * w[i][1]; acc[2] += __uint_as_float(v.y << 16) * w[i][2]; acc[3] += __uint_as_float(v.y & 0xffff0000u) * w[i][3];
                acc[4] += __uint_as_float(v.z << 16) * w[i][4]; acc[5] += __uint_as_float(v.z & 0xffff0000u) * w[i][5]; acc[6] += __uint_as_float(v.w << 16) * w[i][6]; acc[7] += __uint_as_float(v.w & 0xffff0000u) * w[i][7]; }
            u32x4 o; o.x = pk2(siluf(acc[0]), siluf(acc[1])); o.y = pk2(siluf(acc[2]), siluf(acc[3])); o.z = pk2(siluf(acc[4]), siluf(acc[5])); o.w = pk2(siluf(acc[6]), siluf(acc[7]));
            *(u32x4*)(F.XC + (size_t)(tbase + t) * XBCW + c0) = o;
        }
    }
}
__device__ __forceinline__ int ximg_off(int s, int p) { return s * 128 + ((((p >> 4) ^ ((s >> 1) & 3))) << 5) + (p & 15) * 2; }

__device__ __forceinline__ void p4_states(const Ctx& F) {
    const int lane = lane_id_fresh(), wave = F.wave, tid = wave * 64 + lane, fr = lane & 15, fq = lane >> 4;
    LAS unsigned char* BIMG = F.lds;
    LAS unsigned char* XIMG = F.lds + 32768;
    LAS float* WTAB = (LAS float*)(F.lds + 98304);
    for (int u = F.bid; u < 256; u += F.G) {
        const int g = u & 1, c = (u >> 1) & 63, b = u >> 7; const size_t t0 = (size_t)b * SEQ + c * 128;
        const int b_rsub = tid >> 4, b_c16 = tid & 15, x_rsub = tid >> 5, x_c32 = tid & 31;
        const bf16_t* bgp = F.XC + (t0 + b_rsub) * XBCW + 1024 + g * 128 + b_c16 * 8;
        const bf16_t* xgp = F.XC + (t0 + x_rsub) * XBCW + (g * 8) * 64 + x_c32 * 8;
        LAS unsigned char* blp = BIMG + b_rsub * 256 + (((b_c16 >> 1) ^ (b_rsub & 7)) << 5) + (b_c16 & 1) * 16;
        LAS unsigned char* xlp = XIMG + (x_c32 >> 3) * 16384 + x_rsub * 128 + ((((x_c32 & 7) >> 1) ^ ((x_rsub >> 1) & 3)) << 5) + (x_c32 & 1) * 16;
        u32x4 bi[4], xi[8];
#pragma unroll
        for (int i = 0; i < 4; ++i) bi[i] = *(const u32x4*)(bgp + (size_t)i * 32 * XBCW);
#pragma unroll
        for (int i = 0; i < 8; ++i) xi[i] = *(const u32x4*)(xgp + (size_t)i * 16 * XBCW);
        {
            const int hd = g * 8 + wave;
            float a2v[2], d0v[2], d1v[2];
#pragma unroll
            for (int dir = 0; dir < 2; ++dir) { a2v[dir] = F.a_log[dir * 16 + hd]; d0v[dir] = F.DT[(t0 + lane) * 32 + dir * 16 + hd]; d1v[dir] = F.DT[(t0 + 64 + lane) * 32 + dir * 16 + hd]; }
#pragma unroll
            for (int dir = 0; dir < 2; ++dir) {
                const float a2 = -__expf(a2v[dir]) * LOG2E;
                const float d0 = d0v[dir], d1 = d1v[dir];
                float p0 = a2 * d0, p1 = a2 * d1;
#pragma unroll
                for (int o = 1; o < 64; o <<= 1) { const float q0 = __shfl_up(p0, o), q1 = __shfl_up(p1, o); if (lane >= o) { p0 += q0; p1 += q1; } }
                const float tot0 = __shfl(p0, 63), tot1 = __shfl(p1, 63), tot = tot0 + tot1;
                float c0, c1, w0, w1;
                if (dir == 0) { c0 = p0; c1 = tot0 + p1; w0 = exp2f(tot - c0) * d0; w1 = exp2f(tot - c1) * d1; }
                else { c0 = tot - (p0 - a2 * d0); c1 = tot - (tot0 + p1 - a2 * d1); w0 = exp2f(tot - c0) * d0; w1 = exp2f(tot - c1) * d1; }
                F.CUM[(t0 + lane) * 32 + dir * 16 + hd] = c0; F.CUM[(t0 + 64 + lane) * 32 + dir * 16 + hd] = c1;
                WTAB[(dir * 8 + wave) * 128 + lane] = w0; WTAB[(dir * 8 + wave) * 128 + 64 + lane] = w1;
                if (lane == 0) F.CHDEC[((b * 2 + dir) * 64 + c) * 16 + hd] = exp2f(tot);
            }
        }
#pragma unroll
        for (int i = 0; i < 4; ++i) *(LAS u32x4*)(blp + i * 32 * 256) = bi[i];
#pragma unroll
        for (int i = 0; i < 8; ++i) *(LAS u32x4*)(xlp + i * 16 * 128) = xi[i];
        __syncthreads();
#pragma unroll
        for (int i = 0; i < 8; ++i) xi[i] = *(const u32x4*)(xgp + 4 * 64 + (size_t)i * 16 * XBCW);
        auto quad = [&](const int hq) __attribute__((always_inline)) {
            const int q = wave >> 1, dir = wave & 1, hd = g * 8 + hq * 4 + q;
            const LAS float* wt = WTAB + (dir * 8 + hq * 4 + q) * 128 + 4 * fq;
            const int rq = (lane & 15) >> 2, cq = lane & 3, rl = 4 * fq + rq;
            const LAS unsigned char* xrow = XIMG + q * 16384 + rl * 128 + cq * 8;
            const LAS unsigned char* brow = BIMG + rl * 256 + cq * 8;
            const int xsw = (rl >> 1) & 3, bsw = rl & 7;
            bf16_t* So = F.STATES + ((size_t)((b * 2 + dir) * 64 + c) * 16 + hd) * 8192;
#pragma unroll 1
            for (int nh = 0; nh < 2; ++nh) {
                f32x4 acc[4][4];
#pragma unroll
                for (int nt = 0; nt < 4; ++nt)
#pragma unroll
                    for (int pt = 0; pt < 4; ++pt) acc[nt][pt] = (f32x4){0.f, 0.f, 0.f, 0.f};
#pragma unroll
                for (int ks = 0; ks < 4; ++ks) {
                    const f32x4 w1 = *(const LAS f32x4*)(wt + 32 * ks), w2 = *(const LAS f32x4*)(wt + 32 * ks + 16);
                    bf16x8 xb[4];
#pragma unroll
                    for (int pt = 0; pt < 4; ++pt) {
                        const LAS unsigned char* xp = xrow + ((pt ^ xsw) << 5);
                        const s16x4 a = tr_read(xp + (32 * ks) * 128), bq = tr_read(xp + (32 * ks + 16) * 128);
                        u32x4 o;
                        o.x = cvtpk(bf2f((bf16_t)a[0]) * w1[0], bf2f((bf16_t)a[1]) * w1[1]); o.y = cvtpk(bf2f((bf16_t)a[2]) * w1[2], bf2f((bf16_t)a[3]) * w1[3]);
                        o.z = cvtpk(bf2f((bf16_t)bq[0]) * w2[0], bf2f((bf16_t)bq[1]) * w2[1]); o.w = cvtpk(bf2f((bf16_t)bq[2]) * w2[2], bf2f((bf16_t)bq[3]) * w2[3]);
                        xb[pt] = __builtin_bit_cast(bf16x8, o);
                    }
#pragma unroll
                    for (int nt = 0; nt < 4; ++nt) {
                        const LAS unsigned char* bp = brow + (((nh * 4 + nt) ^ bsw) << 5);
                        const bf16x8 bt = cat8(tr_read(bp + (32 * ks) * 256), tr_read(bp + (32 * ks + 16) * 256));
#pragma unroll
                        for (int pt = 0; pt < 4; ++pt) acc[nt][pt] = __builtin_amdgcn_mfma_f32_16x16x32_bf16(bt, xb[pt], acc[nt][pt], 0, 0, 0);
                    }
                }
#pragma unroll
                for (int nt = 0; nt < 4; ++nt)
#pragma unroll
                    for (int pt = 0; pt < 4; ++pt) { u32x2 o; o.x = cvtpk(acc[nt][pt][0], acc[nt][pt][1]); o.y = cvtpk(acc[nt][pt][2], acc[nt][pt][3]);
                        *(u32x2*)(So + (16 * pt + fr) * 128 + 16 * (nh * 4 + nt) + 4 * fq) = o; }
            }
        };
        quad(0);
        __syncthreads();
#pragma unroll
        for (int i = 0; i < 8; ++i) *(LAS u32x4*)(xlp + i * 16 * 128) = xi[i];
        __syncthreads();
        quad(1);
        __syncthreads();
    }
}

__device__ __forceinline__ void p5_scan(const Ctx& F) {
    const int NTH = F.G * NTHREADS, f_tid = F.wave * 64 + lane_id_fresh();
    for (int gid = F.bid * NTHREADS + f_tid; gid < 2 * 2 * 16 * 64 * 32; gid += NTH) {
        const int n4 = gid & 31, p = (gid >> 5) & 63, hd = (gid >> 11) & 15, dir = (gid >> 15) & 1, b = gid >> 16;
        const size_t eoff = ((size_t)((b * 2 + dir) * 64) * 16 + hd) * 8192 + p * 128 + n4 * 4;
        const bf16_t* base = F.STATES + eoff; bf16_t* obase = F.HPREV + eoff;
        const float* dec = F.CHDEC + ((b * 2 + dir) * 64) * 16 + hd;
        float h0 = 0.f, h1 = 0.f, h2 = 0.f, h3 = 0.f;
#pragma unroll 8
        for (int i = 0; i < 64; ++i) {
            const int c = dir ? 63 - i : i;
            const u32x2 s = *(const u32x2*)(base + (size_t)c * 16 * 8192); const float d = dec[c * 16];
            u32x2 o; o.x = pk2(h0, h1); o.y = pk2(h2, h3); *(u32x2*)(obase + (size_t)c * 16 * 8192) = o;
            h0 = h0 * d + __uint_as_float(s.x << 16); h1 = h1 * d + __uint_as_float(s.x & 0xffff0000u); h2 = h2 * d + __uint_as_float(s.y << 16); h3 = h3 * d + __uint_as_float(s.y & 0xffff0000u);
        }
    }
}

__device__ __forceinline__ void p6_ssd_out(const Ctx& F) {
    const int lane = lane_id_fresh(), wave = F.wave, fr = lane & 15, fq = lane >> 4;
    LAS unsigned char* BIMG = F.lds;
    LAS unsigned char* XIMG = F.lds + 32768;
    LAS unsigned char* HST = F.lds + 65536;
    LAS float* TABS = (LAS float*)(F.lds + LDSCTL_OFF + 2048);
    LAS float* GSS = (LAS float*)(F.lds + LDSCTL_OFF + 10240);
#pragma unroll 1
    for (int u = F.bid; u < 256; u += F.G) {
        const int tid = wave * 64 + lane_id_fresh();
        const int g = u & 1, c = (u >> 1) & 63, b = u >> 7; const size_t t0 = (size_t)b * SEQ + c * 128;
        const int lrow = 16 * wave + fr;
        __syncthreads();
        if (tid < 256) *(LAS f32x4*)(GSS + 4 * tid) = *(const f32x4*)(F.g_ssd + 4 * tid); else if (tid < 272) GSS[1024 + tid - 256] = F.d_skip[tid - 256];
        { const int i_rsub = tid >> 5, i_c32 = tid & 31, i_row = 2 * i_rsub + (i_c32 >> 4), i_c16 = i_c32 & 15;
            const bf16_t* gp = F.XC + (t0 + i_row) * XBCW + 1024 + g * 128 + i_c16 * 8;
            LAS unsigned char* lp = BIMG + i_row * 256 + ((i_c16 ^ (i_row & 15)) << 4);
            u32x4 bi[4];
#pragma unroll
            for (int i = 0; i < 4; ++i) bi[i] = *(const u32x4*)(gp + (size_t)i * 32 * XBCW);
            asm volatile("" : "+v"(bi[0]), "+v"(bi[1]), "+v"(bi[2]), "+v"(bi[3]));
#pragma unroll
            for (int i = 0; i < 4; ++i) *(LAS u32x4*)(lp + i * 32 * 256) = bi[i]; }
        u32x4 xr[2]; float tr0;
        const int x_rsub = tid >> 3, x_c8 = tid & 7;
        const bf16_t* xg = F.XC + (t0 + x_rsub) * XBCW + (g * 8) * 64 + x_c8 * 8;
        LAS unsigned char* xl = XIMG + x_rsub * 128 + (((x_c8 >> 1) ^ ((x_rsub >> 1) & 3)) << 5) + (x_c8 & 1) * 16;
        const int t_arr = tid >> 7, t_l = tid & 127;
        const float* tg = ((t_arr >> 1) ? F.DT : F.CUM) + (t0 + t_l) * 32 + (t_arr & 1) * 16 + g * 8;
        LAS float* tl = TABS + t_arr * 128 + t_l;
#define LOAD_X(step) do { _Pragma("unroll") for (int i = 0; i < 2; ++i) xr[i] = *(const u32x4*)(xg + (step) * 64 + (size_t)i * 64 * XBCW); tr0 = tg[(step)]; } while (0)
#define STORE_X(buf) do { _Pragma("unroll") for (int i = 0; i < 2; ++i) *(LAS u32x4*)(xl + (buf) * 16384 + i * 64 * 128) = xr[i]; tl[(buf) * 512] = tr0; } while (0)
        int hoff[4];
#pragma unroll
        for (int k = 0; k < 4; ++k) hoff[k] = (lane >> 4) * 128 + (((lane & 15) ^ (4 * k + (lane >> 4))) << 3);
#define H_DMA(step, buf) do { _Pragma("unroll") for (int j = 0; j < 4; ++j) { const int P = wave * 4 + j, dir = P >> 4, pp = P & 15; \
            const bf16_t* hb = F.HPREV + ((size_t)((b * 2 + dir) * 64 + c) * 16 + g * 8 + (step)) * 8192 + pp * 512; \
            __builtin_amdgcn_global_load_lds((const unsigned*)(hb + hoff[j]), (LAS unsigned*)(HST + (buf) * 32768 + dir * 16384 + pp * 1024), 16, 0, 0); } } while (0)
        LOAD_X(0);
        H_DMA(0, 0);
        float ssq = 0.f;
        u32x2 zvn[4];
        const int rq = (lane & 15) >> 2, cq = lane & 3, rl = 4 * fq + rq, xsw = (rl >> 1) & 3;
        const int xself = lrow * 128 + 8 * fq, xselfsw = (lrow >> 1) & 3;
        const size_t tok = t0 + lrow;
        const int ldiff = lrow - 4 * fq;
        const bf16_t* zg = F.PROJ + tok * NPROJ + C_Z + (g * 8) * 64 + 4 * fq;
#pragma unroll
        for (int pt = 0; pt < 4; ++pt) zvn[pt] = *(const u32x2*)(zg + 16 * pt);
        bf16x8 cfr[4]; f32x4 G[8];
#pragma unroll
        for (int ks = 0; ks < 4; ++ks) cfr[ks] = *(const bf16x8*)(F.XC + tok * XBCW + 1280 + g * 128 + 32 * ks + 8 * fq);
        __syncthreads();
#pragma unroll
        for (int st = 0; st < 8; ++st) { f32x4 a = (f32x4){0.f, 0.f, 0.f, 0.f}; const int s = 16 * st + fr;
#pragma unroll
            for (int ks = 0; ks < 4; ++ks) { const bf16x8 bfrag = *(const LAS bf16x8*)(BIMG + s * 256 + (((4 * ks + fq) ^ fr) << 4));
                a = __builtin_amdgcn_mfma_f32_16x16x32_bf16(bfrag, cfr[ks], a, 0, 0, 0); }
            G[st] = a; }
        STORE_X(0);
#pragma unroll 1
        for (int step = 0; step < 8; ++step) {
            const int hd = g * 8 + step, buf = step & 1;
            if (step == 0) asm volatile("s_waitcnt vmcnt(0)" ::: "memory"); else asm volatile("s_waitcnt vmcnt(4)" ::: "memory");
            __syncthreads();
            u32x2 zv[4];
#pragma unroll
            for (int pt = 0; pt < 4; ++pt) zv[pt] = zvn[pt];
            if (step < 7) { H_DMA(step + 1, buf ^ 1); LOAD_X(step + 1);
#pragma unroll
                for (int pt = 0; pt < 4; ++pt) zvn[pt] = *(const u32x2*)(zg + (step + 1) * 64 + 16 * pt); }
            const LAS unsigned char* xi = XIMG + buf * 16384;
            const LAS unsigned char* xrow = xi + rl * 128 + cq * 8;
            const LAS float* tb = TABS + buf * 512;
            const float cfl = tb[lrow], cbl = tb[128 + lrow];
            f32x4 acc[4];
#pragma unroll
            for (int pt = 0; pt < 4; ++pt) acc[pt] = (f32x4){0.f, 0.f, 0.f, 0.f};
#pragma unroll
            for (int dir = 0; dir < 2; ++dir) {
                f32x4 aco[4];
#pragma unroll
                for (int pt = 0; pt < 4; ++pt) aco[pt] = (f32x4){0.f, 0.f, 0.f, 0.f};
                const LAS unsigned char* hs = HST + buf * 32768 + dir * 16384 + fr * 256;
#pragma unroll
                for (int ks = 0; ks < 4; ++ks) {
                    u32x4 hf_[4];
                    const unsigned ha = (unsigned)(unsigned long long)(hs + (((4 * ks + fq) ^ fr) << 4));
                    hf_[0] = lds_read_a<0>(ha); hf_[1] = lds_read_a<4096>(ha); hf_[2] = lds_read_a<8192>(ha); hf_[3] = lds_read_a<12288>(ha);
                    lds_wait4(hf_);
#pragma unroll
                    for (int pt = 0; pt < 4; ++pt) aco[pt] = __builtin_amdgcn_mfma_f32_16x16x32_bf16(__builtin_bit_cast(bf16x8, hf_[pt]), cfr[ks], aco[pt], 0, 0, 0);
                }
                const float el = __builtin_amdgcn_exp2f(dir ? cbl : cfl);
#pragma unroll
                for (int pt = 0; pt < 4; ++pt) acc[pt] = acc[pt] + aco[pt] * el;
            }
            bf16x8 mop[4];
#pragma unroll
            for (int ks = 0; ks < 4; ++ks) {
                unsigned pk[4];
#pragma unroll
                for (int hf = 0; hf < 2; ++hf) {
                    const int st = 2 * ks + hf;
                    const LAS float* ts = tb + 4 * fq + 16 * st;
                    const f32x4 cfs = *(const LAS f32x4*)(ts), cbs = *(const LAS f32x4*)(ts + 128), dfs = *(const LAS f32x4*)(ts + 256), dbs = *(const LAS f32x4*)(ts + 384);
                    float mv[4];
#pragma unroll
                    for (int i = 0; i < 4; ++i) { const bool fw = (16 * st + i) <= ldiff;
                        const float ar = fw ? cfl - cfs[i] : cbl - cbs[i], wg = fw ? dfs[i] : dbs[i];
                        float v = __builtin_amdgcn_exp2f(ar) * wg; if ((16 * st + i) == ldiff) v += dbs[i];
                        mv[i] = v * G[st][i]; }
                    pk[2 * hf] = cvtpk(mv[0], mv[1]); pk[2 * hf + 1] = cvtpk(mv[2], mv[3]);
                }
                mop[ks] = __builtin_bit_cast(bf16x8, (u32x4){pk[0], pk[1], pk[2], pk[3]});
            }
#pragma unroll
            for (int pt = 0; pt < 4; ++pt) { const unsigned xp = (unsigned)(unsigned long long)(xrow + ((pt ^ xsw) << 5));
                u32x2 t[8];
                t[0] = tr_read_a<0>(xp); t[1] = tr_read_a<2048>(xp); t[2] = tr_read_a<4096>(xp); t[3] = tr_read_a<6144>(xp);
                t[4] = tr_read_a<8192>(xp); t[5] = tr_read_a<10240>(xp); t[6] = tr_read_a<12288>(xp); t[7] = tr_read_a<14336>(xp);
                tr_wait8(t);
#pragma unroll
                for (int ks = 0; ks < 4; ++ks) { const bf16x8 xa = __builtin_bit_cast(bf16x8, (u32x4){t[2 * ks].x, t[2 * ks].y, t[2 * ks + 1].x, t[2 * ks + 1].y});
                    acc[pt] = __builtin_amdgcn_mfma_f32_16x16x32_bf16(xa, mop[ks], acc[pt], 0, 0, 0); } }
            if (step < 7) { STORE_X(buf ^ 1); asm volatile("" : "+v"(zvn[0]), "+v"(zvn[1]), "+v"(zvn[2]), "+v"(zvn[3])); }
            const float dsk = GSS[1024 + hd];
#pragma unroll
            for (int pt = 0; pt < 4; ++pt) {
                const int p0 = 16 * pt + 4 * fq;
                const u32x2 xv = *(const LAS u32x2*)(xi + xself + ((pt ^ xselfsw) << 5));
                const f32x4 gs = *(const LAS f32x4*)(GSS + hd * 64 + p0);
                const float xf[4] = {__uint_as_float(xv.x << 16), __uint_as_float(xv.x & 0xffff0000u), __uint_as_float(xv.y << 16), __uint_as_float(xv.y & 0xffff0000u)};
                const float zf[4] = {__uint_as_float(zv[pt].x << 16), __uint_as_float(zv[pt].x & 0xffff0000u), __uint_as_float(zv[pt].y << 16), __uint_as_float(zv[pt].y & 0xffff0000u)};
                float o[4];
#pragma unroll
                for (int i = 0; i < 4; ++i) { const float y = (acc[pt][i] + dsk * xf[i]) * siluf(zf[i]); ssq += y * y; o[i] = y * gs[i]; }
                u32x2 w; w.x = cvtpk(o[0], o[1]); w.y = cvtpk(o[2], o[3]);
                *(u32x2*)(F.MIXIN + tok * 2048 + hd * 64 + p0) = w;
            }
        }
#undef LOAD_X
#undef STORE_X
#undef H_DMA
        ssq += __shfl_xor(ssq, 16); ssq += __shfl_xor(ssq, 32);
        if (fq == 0) F.RR[(size_t)g * TT + tok] = ssq;
    }
}
__device__ __forceinline__ void p7_postmix(const Ctx& F) {
    const int lane = lane_id_fresh(), wave = F.wave, tid = wave * 64 + lane, fr = lane & 15, fq = lane >> 4;
    LAS unsigned char* HL = F.lds;
    LAS float* PART = (LAS float*)(F.lds + 65536);
    LAS int* SEL = (LAS int*)(F.lds + 81920);
    LAS float* SELW = (LAS float*)(F.lds + 82944);
    LAS int* HIST = (LAS int*)(F.lds + 83968);
    LAS float* CST = (LAS float*)(F.lds + 86016);
    unsigned* ecount = F.ctl + CW_ECOUNT;
    bf16x8 wh[2][4], wl[2][4];
#pragma unroll
    for (int et = 0; et < 2; ++et)
#pragma unroll
        for (int ks = 0; ks < 4; ++ks) { const bf16_t* p = F.WRT + (16 * et + fr) * DM + 128 * wave + 32 * ks + 8 * fq; wh[et][ks] = *(const bf16x8*)p; wl[et][ks] = *(const bf16x8*)(p + NEXP * DM); }
    for (int blk = F.bid; blk < TT / 64; blk += F.G) {
        if (tid < 32) HIST[tid] = 0;
        { const float* mb = F.mod + ((blk * 64) / SEQ) * 6144;
            for (int i = tid; i < 1280; i += NTHREADS) { const int a = i >> 8, c4 = (i & 255) * 4;
                const float* sp = a == 0 ? mb + 2048 : a == 1 ? F.g_post_mix : a == 2 ? F.g_pre_ffn : a == 3 ? mb + 4096 : mb + 3072;
                *(LAS f32x4*)(CST + a * 1024 + c4) = *(const f32x4*)(sp + c4); } }
        u32x2 qn[4]; f32x4 xn[4];
#define PM_LOAD(idx) do { const size_t t_ = (size_t)(blk * 64 + ((idx) >> 1) * 16 + 2 * wave + ((idx) & 1)) * DM + 4 * lane; _Pragma("unroll") for (int j = 0; j < 4; ++j) { \
            qn[j] = *(const u32x2*)(F.MIX + t_ + 256 * j); xn[j] = *(const f32x4*)(F.x + t_ + 256 * j); } } while (0)
        PM_LOAD(0);
        __syncthreads();
#pragma unroll
        for (int grp = 0; grp < 4; ++grp) {
#pragma unroll
            for (int rr = 0; rr < 2; ++rr) {
                const int row = 2 * wave + rr, t = blk * 64 + grp * 16 + row;
                float mv[16], rv[16]; float ss = 0.f;
                f32x4 xc[4];
#pragma unroll
                for (int j = 0; j < 4; ++j) { const u32x2 q = qn[j]; xc[j] = xn[j];
                    const f32x4 v = (f32x4){__uint_as_float(q.x << 16), __uint_as_float(q.x & 0xffff0000u), __uint_as_float(q.y << 16), __uint_as_float(q.y & 0xffff0000u)};
                    mv[4 * j] = v.x; mv[4 * j + 1] = v.y; mv[4 * j + 2] = v.z; mv[4 * j + 3] = v.w; ss += v.x * v.x + v.y * v.y + v.z * v.z + v.w * v.w; }
                if (grp * 2 + rr < 7) PM_LOAD(grp * 2 + rr + 1);
                const float r = rsqrtf(wave_sum(ss) * (1.f / DM) + RMS_EPS);
                float ss2 = 0.f;
#pragma unroll
                for (int j = 0; j < 4; ++j) { const int c0 = 4 * lane + 256 * j; const f32x4 xv = xc[j], gm = *(const LAS f32x4*)(CST + c0), gp = *(const LAS f32x4*)(CST + 1024 + c0);
#pragma unroll
                    for (int i = 0; i < 4; ++i) { const float v = xv[i] + gm[i] * (mv[4 * j + i] * r * gp[i]); rv[4 * j + i] = v; ss2 += v * v; } }
                const float r2 = rsqrtf(wave_sum(ss2) * (1.f / DM) + RMS_EPS);
#pragma unroll
                for (int j = 0; j < 4; ++j) {
                    const int c0 = 4 * lane + 256 * j; const f32x4 gp = *(const LAS f32x4*)(CST + 2048 + c0), sc = *(const LAS f32x4*)(CST + 3072 + c0), sh = *(const LAS f32x4*)(CST + 4096 + c0);
                    float hv[4];
#pragma unroll
                    for (int i = 0; i < 4; ++i) hv[i] = rv[4 * j + i] * r2 * gp[i] * (1.f + sc[i]) + sh[i];
                    { u32x2 rq; rq.x = cvtpk(rv[4 * j], rv[4 * j + 1]); rq.y = cvtpk(rv[4 * j + 2], rv[4 * j + 3]); *(u32x2*)(F.RES + (size_t)t * DM + c0) = rq; }
                    u32x2 hi; hi.x = cvtpk(hv[0], hv[1]); hi.y = cvtpk(hv[2], hv[3]);
                    *(u32x2*)(F.H + (size_t)t * DM + c0) = hi;
                    u32x2 lo; lo.x = cvtpk(hv[0] - __uint_as_float(hi.x << 16), hv[1] - __uint_as_float(hi.x & 0xffff0000u)); lo.y = cvtpk(hv[2] - __uint_as_float(hi.y << 16), hv[3] - __uint_as_float(hi.y & 0xffff0000u));
                    const int chunk = (lane >> 1) + 32 * j, off = row * 4096 + ((chunk ^ row) << 4) + (lane & 1) * 8;
                    *(LAS u32x2*)(HL + off) = hi; *(LAS u32x2*)(HL + 2048 + off) = lo;
                }
            }
            __syncthreads();
            { f32x4 acc[2] = {(f32x4){0.f, 0.f, 0.f, 0.f}, (f32x4){0.f, 0.f, 0.f, 0.f}};
#pragma unroll
                for (int ks = 0; ks < 4; ++ks) { const int off = fr * 4096 + (((16 * wave + 4 * ks + fq) ^ fr) << 4);
                    const bf16x8 ah = *(const LAS bf16x8*)(HL + off), al = *(const LAS bf16x8*)(HL + 2048 + off);
#pragma unroll
                    for (int et = 0; et < 2; ++et) { acc[et] = __builtin_amdgcn_mfma_f32_16x16x32_bf16(al, wh[et][ks], acc[et], 0, 0, 0); acc[et] = __builtin_amdgcn_mfma_f32_16x16x32_bf16(ah, wl[et][ks], acc[et], 0, 0, 0);
                        acc[et] = __builtin_amdgcn_mfma_f32_16x16x32_bf16(ah, wh[et][ks], acc[et], 0, 0, 0); } }
#pragma unroll
                for (int et = 0; et < 2; ++et)
#pragma unroll
                    for (int i = 0; i < 4; ++i) PART[(wave * 16 + 4 * fq + i) * 32 + 16 * et + fr] = acc[et][i]; }
            __syncthreads();
            { const int e = lane & 31, row = 2 * wave + (lane >> 5);
                float v = F.b_router[e];
#pragma unroll
                for (int w = 0; w < 8; ++w) v += PART[(w * 16 + row) * 32 + e];
                int ti[4]; float tv[4];
#pragma unroll
                for (int k = 0; k < 4; ++k) {
                    float bv = v; int bi = e;
#pragma unroll
                    for (int o = 16; o >= 1; o >>= 1) { const float ov = __shfl_xor(bv, o); const int oi = __shfl_xor(bi, o); if (ov > bv || (ov == bv && oi < bi)) { bv = ov; bi = oi; } }
                    ti[k] = bi; tv[k] = bv; if (e == bi) v = -INFINITY;
                }
                const float e1 = __expf(tv[1] - tv[0]), e2 = __expf(tv[2] - tv[0]), e3 = __expf(tv[3] - tv[0]), inv = 1.f / (1.f + e1 + e2 + e3);
                if (e < 4) { int ex = ti[0]; float w = inv;
                    if (e == 1) { ex = ti[1]; w = e1 * inv; } else if (e == 2) { ex = ti[2]; w = e2 * inv; } else if (e == 3) { ex = ti[3]; w = e3 * inv; }
                    SEL[(grp * 16 + row) * 4 + e] = ex; SELW[(grp * 16 + row) * 4 + e] = w; } }
            __syncthreads();
        }
#undef PM_LOAD
        int myex = 0, myloc = 0;
        if (tid < 256) { myex = SEL[tid]; myloc = __hip_atomic_fetch_add(&HIST[myex], 1, __ATOMIC_RELAXED, __HIP_MEMORY_SCOPE_WORKGROUP); }
        __syncthreads();
        if (tid < 32) { const int c = HIST[tid]; HIST[32 + tid] = c ? (int)atomicAdd(&ecount[tid], (unsigned)c) : 0; }
        __syncthreads();
        if (tid < 256) { const int slot = (blk * 64 + (tid >> 2)) * 4 + (tid & 3); const int pos = myex * TT + HIST[32 + myex] + myloc; F.SORT[pos] = slot; F.SORTW[pos] = SELW[tid]; }
        __syncthreads();
    }
}
__device__ __forceinline__ void p10_final(const Ctx& F) {
    const int gw = F.bid * NWAVES + F.wave, NGW = F.G * NWAVES, lane = lane_id_fresh();
    for (int t0 = gw; t0 < TT; t0 += 2 * NGW) {
        const int tt[2] = {t0, t0 + NGW < TT ? t0 + NGW : t0};
        u32x2 y[2][4][4], rq[2][4];
#pragma unroll
        for (int q = 0; q < 2; ++q)
#pragma unroll
            for (int j = 0; j < 4; ++j) { const int c0 = 4 * lane + 256 * j;
#pragma unroll
                for (int k = 0; k < 4; ++k) y[q][j][k] = *(const u32x2*)(F.YSLOT + (size_t)(tt[q] * 4 + k) * DM + c0);
                rq[q][j] = *(const u32x2*)(F.RES + (size_t)tt[q] * DM + c0); }
        f32x4 gg[2][4];
#pragma unroll
        for (int q = 0; q < 2; ++q) { const float* gate = F.mod + (tt[q] / SEQ) * 6144 + 5120;
#pragma unroll
            for (int j = 0; j < 4; ++j) { const int c0 = 4 * lane + 256 * j; if (q == 0 || tt[1] / SEQ != tt[0] / SEQ) gg[q][j] = *(const f32x4*)(gate + c0) * *(const f32x4*)(F.g_post_ffn + c0); else gg[q][j] = gg[0][j]; } }
#pragma unroll
        for (int q = 0; q < 2; ++q) {
            const int t = tt[q];
            float f[16]; float ss = 0.f;
#pragma unroll
            for (int j = 0; j < 4; ++j) { float s[4] = {0.f, 0.f, 0.f, 0.f};
#pragma unroll
                for (int k = 0; k < 4; ++k) { const u32x2 v = y[q][j][k];
                    s[0] += __uint_as_float(v.x << 16); s[1] += __uint_as_float(v.x & 0xffff0000u); s[2] += __uint_as_float(v.y << 16); s[3] += __uint_as_float(v.y & 0xffff0000u); }
#pragma unroll
                for (int i = 0; i < 4; ++i) { f[4 * j + i] = s[i]; ss += s[i] * s[i]; } }
            const float r = rsqrtf(wave_sum(ss) * (1.f / DM) + RMS_EPS);
#pragma unroll
            for (int j = 0; j < 4; ++j) { const int c0 = 4 * lane + 256 * j; const f32x4 g4 = gg[q][j]; const u32x2 rr = rq[q][j];
                f32x4 o = (f32x4){__uint_as_float(rr.x << 16), __uint_as_float(rr.x & 0xffff0000u), __uint_as_float(rr.y << 16), __uint_as_float(rr.y & 0xffff0000u)};
#pragma unroll
                for (int i = 0; i < 4; ++i) o[i] += g4[i] * (f[4 * j + i] * r);
                *(f32x4*)(F.out + (size_t)t * DM + c0) = o; }
        }
    }
}

struct Args { const float* in[22]; float* out; unsigned char* ws; int ph_lo, ph_hi; };
__global__ void __launch_bounds__(NTHREADS, 2) mk_fwd(Args args) {
    extern __shared__ __attribute__((aligned(16))) unsigned char lds_raw[];
    Ctx F;
    F.lds = (LAS unsigned char*)lds_raw; F.wave = __builtin_amdgcn_readfirstlane((int)threadIdx.x >> 6); F.G = gridDim.x; F.bid = blockIdx.x;
    unsigned char* ws = args.ws;
    F.x = args.in[0]; F.c = args.in[1]; F.w_ada = args.in[2]; F.b_ada = args.in[3]; F.g_pre_mix = args.in[4]; F.g_post_mix = args.in[5]; F.w_in = args.in[6];
    F.conv_w = args.in[7]; F.conv_b = args.in[8]; F.dt_bias = args.in[9]; F.a_log = args.in[10]; F.d_skip = args.in[11]; F.g_ssd = args.in[12]; F.w_out = args.in[13];
    F.g_pre_ffn = args.in[14]; F.g_post_ffn = args.in[15]; F.w_router = args.in[16]; F.b_router = args.in[17]; F.w_gu = args.in[18]; F.b_gu = args.in[19]; F.w_dn = args.in[20]; F.b_dn = args.in[21];
    F.out = args.out; F.ctl = (unsigned*)(ws + WS_CTL); F.mod = (float*)(ws + WS_MOD);
    F.WIN = (bf16_t*)(ws + WS_WIN); F.WOUT = (bf16_t*)(ws + WS_WOUT); F.WGU = (bf16_t*)(ws + WS_WGU); F.WDN = (bf16_t*)(ws + WS_WDN);
    F.H = (bf16_t*)(ws + WS_H); F.PROJ = (bf16_t*)(ws + WS_PROJ); F.XC = (bf16_t*)(ws + WS_XC); F.DT = (float*)(ws + WS_DT);
    F.STATES = (bf16_t*)(ws + WS_STATES); F.CUM = (float*)(ws + WS_CUM); F.CHDEC = (float*)(ws + WS_CHDEC); F.OPART = (bf16_t*)(ws + WS_OPART); F.HPREV = (bf16_t*)(ws + WS_HPREV); F.WRT = (bf16_t*)(ws + WS_WRT); F.RES = (bf16_t*)(ws + WS_RES); F.LSE = (float*)(ws + WS_LSE); F.MIXIN = (bf16_t*)(ws + WS_MIXIN); F.MIX = (bf16_t*)(ws + WS_MIX);
    F.TOPW = (float*)(ws + WS_TOPW); F.SORT = (int*)(ws + WS_SORT); F.SORTW = (float*)(ws + WS_SORTW); F.RR = (float*)(ws + WS_RR); F.ACT = (bf16_t*)(ws + WS_ACT); F.YSLOT = (bf16_t*)(ws + WS_YSLOT);
    volatile LAS unsigned* LCTL = (volatile LAS unsigned*)(F.lds + LDSCTL_OFF);
    for (int u = (int)threadIdx.x; u < (LDS_BYTES - LDSCTL_OFF) / 4; u += NTHREADS) LCTL[u] = 0u;
    __syncthreads();
    XcdBarrier bar; bar.bar = F.ctl + CW_BAR; bar.x = 0; bar.st = nullptr;
    if (MK_N_LAUNCHES == 1) bar = xcd_barrier_post(F.ctl + CW_BAR, LCTL);
    const int lo = args.ph_lo, hi = args.ph_hi;
#define IN(k) (lo <= (k) && (k) < hi)
Fill fs; fs.pend = -1; fs.mpend = -1; fs.mopen = 0; fs.wdone = 0; fs.mdone = 0;
#define SEAM(k) do { if (IN(k) && IN((k) + 1)) xcd_barrier_fill(bar, F, fs); } while (0)

    if (IN(0)) { for (int rep_ = 0; rep_ < (DUP_PHASE == 0 ? 2 : 1); ++rep_) p0_prologue(F); }
    if (IN(1)) { for (int rep_ = 0; rep_ < (DUP_PHASE == 1 ? 2 : 1); ++rep_) p1_prenorm(F); } SEAM(1);
    if (DUP_PHASE == 20) { for (int rep_ = 0; rep_ < 4; ++rep_) xcd_barrier(bar, F.wave); }
    if (IN(2)) {
        pg8::Gemm g{F.H, F.WIN, DM}; pg8::DenseOrder<TT, NPROJ_PAD, DM> S; S.init(F.G, F.bid);
        pg8::EpiInproj E{F.PROJ, F.DT, F.dt_bias};
        for (int rep_ = 0; rep_ < (DUP_PHASE == 2 ? 2 : 1); ++rep_) pg8::gemm_phase<pg8::EpiInproj, pg8::DenseOrder<TT, NPROJ_PAD, DM>, true>(F.lds, g, S, E, F.wave);
    } SEAM(2);
    if (IN(3)) { for (int rep_ = 0; rep_ < (DUP_PHASE == 3 ? 2 : 1); ++rep_) p3_attention(F); for (int rep_ = 0; rep_ < (DUP_PHASE == 13 ? 2 : 1); ++rep_) p3_conv(F); } SEAM(3);
    fs.mopen = 1;
    if (IN(4)) { for (int rep_ = 0; rep_ < (DUP_PHASE == 4 ? 2 : 1); ++rep_) p4_states(F); } SEAM(4);
    if (IN(5)) { for (int rep_ = 0; rep_ < (DUP_PHASE == 5 ? 2 : 1); ++rep_) p5_scan(F); } SEAM(5);
    if (IN(6)) { for (int rep_ = 0; rep_ < (DUP_PHASE == 6 ? 2 : 1); ++rep_) p6_ssd_out(F); }
    fill_drain(F, fs, 2, 0, LCTL);
    fill_drain(F, fs, 1, FQ_OUT, LCTL);
    SEAM(6);
    if (IN(7)) {
        pg8::Gemm g{F.MIXIN, F.WOUT, 2048}; pg8::DenseOrder<TT, DM, 2048> S; S.init(F.G, F.bid);
        pg8::EpiBf16 E{F.MIX, DM, F.RR};
        for (int rep_ = 0; rep_ < (DUP_PHASE == 7 ? 2 : 1); ++rep_) pg8::gemm_phase<pg8::EpiBf16, pg8::DenseOrder<TT, DM, 2048>, true>(F.lds, g, S, E, F.wave);
    } SEAM(7);
    if (IN(8)) { p7_postmix(F); }
    __syncthreads();
    fill_drain(F, fs, 1, FQ_GU, LCTL);
    SEAM(8);
    if (IN(9) || IN(10)) {
        LAS int* tcum = (LAS int*)(F.lds + LDSCTL_OFF + 64); LAS int* cnt = (LAS int*)(F.lds + LDSCTL_OFF + 256); LAS int* texp = (LAS int*)(F.lds + LDSCTL_OFF + 512);
        const int vcu = (F.G % 8 == 0) ? (F.bid % 8) * (F.G / 8) + F.bid / 8 : F.bid;
        if (F.wave == 0 && lane_id_fresh() == 0) { int cum = 0; for (int e = 0; e < NEXP; ++e) { const int c = (int)__hip_atomic_load(F.ctl + CW_ECOUNT + e, __ATOMIC_RELAXED, __HIP_MEMORY_SCOPE_AGENT); cnt[e] = c; tcum[e] = cum; cum += (c + 255) >> 8; } tcum[NEXP] = cum; }
        __syncthreads();
        { const int rt = F.wave * 64 + lane_id_fresh(); if (rt < 320) { int e = 0; for (int j = 1; j < NEXP; ++j) if (tcum[j] <= rt) e = j; texp[rt] = e; } }
        __syncthreads();
        if (IN(9)) {
            pg8::Gemm g{F.H, F.WGU, DM}; pg8::MoeOrder S{tcum, cnt, texp, F.SORT, 3, F.G, vcu, DM, (size_t)2048 * DM * 2, true};
            pg8::EpiSwiglu E{F.ACT, F.b_gu};
            for (int rep_ = 0; rep_ < (DUP_PHASE == 9 ? 2 : 1); ++rep_) pg8::gemm_phase<pg8::EpiSwiglu, pg8::MoeOrder, true>(F.lds, g, S, E, F.wave);
        }
        __syncthreads();
        fill_drain(F, fs, 1, FQ_ALL, LCTL);
        SEAM(9);
        if (IN(10)) {
            pg8::Gemm g{F.ACT, F.WDN, FF}; pg8::MoeOrder S{tcum, cnt, texp, F.SORT, 2, F.G, vcu, FF, (size_t)DM * FF * 2, false};
            pg8::EpiDown E{F.YSLOT, F.b_dn, F.SORT, F.SORTW};
            for (int rep_ = 0; rep_ < (DUP_PHASE == 10 ? 2 : 1); ++rep_) pg8::gemm_phase<pg8::EpiDown, pg8::MoeOrder, true>(F.lds, g, S, E, F.wave);
        }
    }
    SEAM(10);
    if (IN(11)) { for (int rep_ = 0; rep_ < (DUP_PHASE == 11 ? 2 : 1); ++rep_) p10_final(F); }
#undef IN
#undef SEAM
}

extern "C" void kernel_launch(void* const* d_in, const int* in_sizes, int n_in, void* d_out, int out_size, void* d_ws, size_t ws_size, hipStream_t stream) {
    static int grid = 0;
    if (grid == 0) {
        if (n_in != 22 || ws_size < WS_END) { fprintf(stderr, "kernel_launch: unexpected n_in %d / ws %zu\n", n_in, ws_size); grid = -1; return; }
        int dev = 0, cus = 0, per_cu = 0;
        if (hipGetDevice(&dev) != hipSuccess || hipDeviceGetAttribute(&cus, hipDeviceAttributeMultiprocessorCount, dev) != hipSuccess) { grid = -1; return; }
        if (hipFuncSetAttribute((const void*)mk_fwd, hipFuncAttributeMaxDynamicSharedMemorySize, LDS_BYTES) != hipSuccess) { fprintf(stderr, "kernel_launch: hipFuncSetAttribute failed\n"); grid = -1; return; }
        if (hipOccupancyMaxActiveBlocksPerMultiprocessor(&per_cu, (const void*)mk_fwd, NTHREADS, LDS_BYTES) != hipSuccess || per_cu < 1) fprintf(stderr, "kernel_launch: occupancy query says %d\n", per_cu);
        (void)hipGetLastError();
        grid = cus;
    }
    if (grid < 0) return;
    (void)hipMemsetAsync((char*)d_ws + WS_CTL, 0, CTL_BYTES, stream);
    Args a{};
    for (int i = 0; i < 22; ++i) a.in[i] = (const float*)d_in[i];
    a.out = (float*)d_out; a.ws = (unsigned char*)d_ws;
    for (int li = 0; li < MK_N_LAUNCHES; ++li) {
        if (MK_N_LAUNCHES == 1) { a.ph_lo = 0; a.ph_hi = N_PHASES; } else { a.ph_lo = li; a.ph_hi = li + 1; }
        hipLaunchKernelGGL(mk_fwd, dim3(grid), dim3(NTHREADS), LDS_BYTES, stream, a);
    }
}
```

```cpp
#include <hip/hip_runtime.h>
#include <cstdio>
#include <cstdint>

#define LAS __attribute__((address_space(3)))
#define GAS __attribute__((address_space(1)))
typedef unsigned short bf16_t;
typedef short bf16x8 __attribute__((ext_vector_type(8)));
typedef float f32x4 __attribute__((ext_vector_type(4)));
typedef unsigned u32x4 __attribute__((ext_vector_type(4)));
typedef unsigned u32x2 __attribute__((ext_vector_type(2)));
typedef GAS unsigned gu32;

#ifndef DUP_PHASE
#define DUP_PHASE -1
#endif
#ifndef MK_N_LAUNCHES
#define MK_N_LAUNCHES 1
#endif
constexpr int N_PHASES = 12;

constexpr int BATCH = 2, SEQ = 8192, DM = 1024, TT = BATCH * SEQ;
constexpr int NPROJ = 5632, NPROJ_ALL = 5664, NPROJ_PAD = 5888;
constexpr int C_Q = 0, C_K = 1024, C_V = 2048, C_Z = 3072, C_XBC = 4096;
constexpr int XBCW = 1536;
constexpr int NEXP = 32, FF = 1024;
constexpr float RMS_EPS = 1e-6f;
constexpr int NWAVES = 8, NTHREADS = 512;

constexpr size_t MiB = 1u << 20;
constexpr size_t WS_CTL = 0, CTL_BYTES = 65536;
constexpr size_t WS_MOD = 1 * MiB;
constexpr size_t WS_WIN = 2 * MiB;
constexpr size_t WS_WOUT = 14 * MiB;
constexpr size_t WS_WGU = 18 * MiB;
constexpr size_t WS_WDN = 146 * MiB;
constexpr size_t WS_H = 210 * MiB;
constexpr size_t WS_PROJ = 242 * MiB;
constexpr size_t WS_XC = 418 * MiB;
constexpr size_t WS_DT = 466 * MiB;
constexpr size_t WS_STATES = 468 * MiB;
constexpr size_t WS_CUM = 532 * MiB;
constexpr size_t WS_CHDEC = 534 * MiB;
constexpr size_t WS_MIXIN = 596 * MiB;
constexpr size_t WS_MIX = 660 * MiB;
constexpr size_t WS_TOPW = 724 * MiB;
constexpr size_t WS_SORT = 725 * MiB;
constexpr size_t WS_SORTW = 536 * MiB;
constexpr size_t WS_RR = 538 * MiB;
constexpr size_t WS_ACT = 242 * MiB;
constexpr size_t WS_YSLOT = 386 * MiB;
constexpr size_t WS_WRT = 535 * MiB;
constexpr size_t WS_OPART = 728 * MiB;
constexpr size_t WS_LSE = 824 * MiB;
constexpr size_t WS_HPREV = 828 * MiB;
constexpr size_t WS_RES = 892 * MiB;
constexpr size_t WS_END = 956 * MiB;

constexpr int CW_ECOUNT = 64;
constexpr int CW_MODCNT = 1024;
constexpr int CW_BAR = 4096;
constexpr int CW_FQ = 9216, CW_MQ = 9280;

constexpr int RING_BYTES = 131072;
constexpr int LDSCTL_OFF = RING_BYTES;
constexpr int LDS_BYTES = 147456;

__device__ __forceinline__ float bf2f(bf16_t v) { return __uint_as_float(((unsigned)v) << 16); }
__device__ __forceinline__ bf16_t f2bf(float f) { unsigned u = __float_as_uint(f); return (bf16_t)((u + 0x7fffu + ((u >> 16) & 1u)) >> 16); }
typedef float f32x2_t __attribute__((ext_vector_type(2))); typedef __bf16 bf16x2_t __attribute__((ext_vector_type(2)));
__device__ __forceinline__ unsigned pk2(float lo, float hi) { f32x2_t v = {lo, hi}; bf16x2_t b = __builtin_convertvector(v, bf16x2_t); return __builtin_bit_cast(unsigned, b); }
__device__ __forceinline__ float wave_sum(float v) {
#pragma unroll
    for (int o = 1; o < 64; o <<= 1) v += __shfl_xor(v, o);
    return v;
}
__device__ __forceinline__ float siluf(float x) { return x * __builtin_amdgcn_rcpf(1.f + __expf(-x)); }
#define LDS_WAIT() asm volatile("s_waitcnt lgkmcnt(0)" ::: "memory")
__device__ __forceinline__ int lane_id_fresh() { int l; asm volatile("v_mbcnt_lo_u32_b32 %0, -1, 0\n\tv_mbcnt_hi_u32_b32 %0, -1, %0" : "=v"(l)); return l; }

namespace pg8 {
constexpr int BM = 256, BK = 64, HALF = 128, HTB = HALF * BK * 2, STAGE_BYTES = 8 * HTB;
__host__ __device__ __forceinline__ int lds_byte(int r, int c) { const int st = (r >> 4) * 2 + (c >> 5), rr = r & 15, cc = c & 31, ob = rr * 64 + cc * 2; return st * 1024 + (ob ^ (((ob >> 9) & 1) << 5)); }
__host__ __device__ __forceinline__ void stage_rc(int b, int& R, int& C) { const int st = b / 1024, sb = b % 1024, swz = sb ^ (((sb >> 9) & 1) << 5); R = (st >> 1) * 16 + swz / 64; C = (st & 1) * 32 + (swz % 64) / 2; }
__host__ __device__ __forceinline__ int perm32(int rho) { const int n = rho >> 4, i = rho & 15; return 8 * (i >> 2) + 4 * n + (i & 3); }

struct Unit { int pm, pn, arow0, e, nvalid, lrow0; size_t boff; };
struct Gemm { const bf16_t* A; const bf16_t* Bt; int K; };

template <int M_, int N_, int K_>
struct DenseOrder {
    static constexpr int nM = M_ / BM, nN = N_ / BM, nwg = nM * nN, K = K_;
    int G, c;
    __device__ void init(int G_, int c_) { G = G_; c = c_; }
    __device__ __forceinline__ bool next(int i, Unit& u) const {
        const long L = (long)i * G + c; if (L >= nwg) return false;
        int wgid = (int)L; { const int q = nwg / 8, r = nwg % 8, xcd = wgid % 8, off = wgid / 8; wgid = (xcd < r ? xcd * (q + 1) : r * (q + 1) + (xcd - r) * q) + off; }
        const int nig = 8 * nN, gid = wgid / nig, fm = gid * 8, gsz = (nM - fm) < 8 ? (nM - fm) : 8;
        u.pm = fm + ((wgid % nig) % gsz); u.pn = (wgid % nig) / gsz; u.arow0 = u.pm * BM; u.e = 0; u.nvalid = BM; u.lrow0 = 0; u.boff = (size_t)u.pn * BM * K * 2; return true;
    }
    __device__ __forceinline__ void a_off(const Unit& u, const int (&R)[2], const int (&C)[2], unsigned (&off)[2][2]) const {
#pragma unroll
        for (int h = 0; h < 2; ++h)
#pragma unroll
            for (int i = 0; i < 2; ++i) off[h][i] = (unsigned)(((size_t)(u.arow0 + h * HALF + R[i]) * K + C[i]) * 2);
    }
};
struct MoeOrder {
    const LAS int* tcum; const LAS int* cnt; const LAS int* texp; const int* sorted; int nNsh, G, c, K; size_t estride; bool gather;
    __device__ __forceinline__ bool next(int i, Unit& u) const {
        const int L = i * G + c, NT = tcum[NEXP]; if (L >= (NT << nNsh)) return false;
        const int rt = L >> nNsh; u.pn = L & ((1 << nNsh) - 1); u.pm = rt;
        const int e = texp[rt];
        u.e = e; u.lrow0 = (rt - tcum[e]) * BM; u.nvalid = min(BM, cnt[e] - u.lrow0); u.arow0 = rt * BM;
        u.boff = (size_t)e * estride + (size_t)u.pn * BM * K * 2; return true;
    }
    __device__ __forceinline__ void a_off(const Unit& u, const int (&R)[2], const int (&C)[2], unsigned (&off)[2][2]) const {
#pragma unroll
        for (int h = 0; h < 2; ++h)
#pragma unroll
            for (int i = 0; i < 2; ++i) {
                const int r = h * HALF + R[i];
                int row;
                if (gather) { const int rr = r < u.nvalid ? r : 0; row = sorted[u.e * TT + u.lrow0 + rr] >> 2; } else row = u.arow0 + r;
                off[h][i] = (unsigned)(((size_t)row * K + C[i]) * 2);
            }
    }
};

__device__ __forceinline__ unsigned cvt_pk_bf16(float lo, float hi) { f32x2_t v = {lo, hi}; bf16x2_t b = __builtin_convertvector(v, bf16x2_t); return __builtin_bit_cast(unsigned, b); }

constexpr int PF_OFF = 131072 + 10240, PF_BYTES = 3072;
struct EpiInproj {
    static constexpr bool PERM = true, PREFETCH = false, MIDSCALE = false;
    bf16_t* O; float* DT; const float* dt_bias;
    __device__ __forceinline__ void operator()(const f32x4 (&acc)[2][2][4][2], const Unit& u, int wr, int wc, int fr, int fq, const LAS unsigned char*) const {
        const int row0 = u.arow0 + wr * 64 + fr;
        if (u.pn < NPROJ / BM) {
            const float sc = (u.pn < 4) ? 0.125f * 1.4426950408889634f : 1.f;
            const int col0 = u.pn * BM + wc * 32 + 8 * fq;
#pragma unroll
            for (int ai = 0; ai < 2; ++ai)
#pragma unroll
                for (int m = 0; m < 4; ++m) { bf16_t* rowp = O + (size_t)(row0 + ai * HALF + m * 16) * NPROJ + col0;
#pragma unroll
                    for (int bj = 0; bj < 2; ++bj) { const f32x4 v0 = acc[ai][bj][m][0] * sc, v1 = acc[ai][bj][m][1] * sc;
                        u32x4 w; w.x = cvt_pk_bf16(v0[0], v0[1]); w.y = cvt_pk_bf16(v0[2], v0[3]); w.z = cvt_pk_bf16(v1[0], v1[1]); w.w = cvt_pk_bf16(v1[2], v1[3]);
                        *(u32x4*)(rowp + bj * HALF) = w; } }
        } else if (wc == 0) {
            const int c0 = 8 * fq; const f32x4 b0 = *(const f32x4*)(dt_bias + c0), b1 = *(const f32x4*)(dt_bias + c0 + 4);
#pragma unroll
            for (int ai = 0; ai < 2; ++ai)
#pragma unroll
                for (int m = 0; m < 4; ++m) { float* rowp = DT + (size_t)(row0 + ai * HALF + m * 16) * 32 + c0;
                    f32x4 v0 = acc[ai][0][m][0] + b0, v1 = acc[ai][0][m][1] + b1;
#pragma unroll
                    for (int j = 0; j < 4; ++j) { v0[j] = v0[j] > 20.f ? v0[j] : log1pf(__expf(v0[j])); v1[j] = v1[j] > 20.f ? v1[j] : log1pf(__expf(v1[j])); }
                    *(f32x4*)(rowp) = v0; *(f32x4*)(rowp + 4) = v1; }
        }
    }
};
struct EpiBf16 {
    static constexpr bool PERM = true, PREFETCH = false, MIDSCALE = true;
    bf16_t* O; int ldc; const float* rr;
    __device__ __forceinline__ void operator()(const f32x4 (&acc)[2][2][4][2], const Unit& u, int wr, int wc, int fr, int fq, const LAS unsigned char*) const {
        const int row0 = u.arow0 + wr * 64 + fr, col0 = u.pn * BM + wc * 32 + 8 * fq;
#pragma unroll
        for (int ai = 0; ai < 2; ++ai)
#pragma unroll
            for (int m = 0; m < 4; ++m) { bf16_t* rowp = O + (size_t)(row0 + ai * HALF + m * 16) * ldc + col0;
#pragma unroll
                for (int bj = 0; bj < 2; ++bj) { const f32x4 v0 = acc[ai][bj][m][0], v1 = acc[ai][bj][m][1];
                    u32x4 w; w.x = cvt_pk_bf16(v0[0], v0[1]); w.y = cvt_pk_bf16(v0[2], v0[3]); w.z = cvt_pk_bf16(v1[0], v1[1]); w.w = cvt_pk_bf16(v1[2], v1[3]);
                    *(u32x4*)(rowp + bj * HALF) = w; } }
    }
};
struct EpiSwiglu {
    static constexpr bool PERM = true, PREFETCH = true, MIDSCALE = false;
    bf16_t* ACT; const float* b_gu;
    __device__ __forceinline__ void prefetch(const Unit& u, LAS unsigned char* pf, int wid, int lane) const {
        if (wid == 0) __builtin_amdgcn_global_load_lds((const unsigned*)(b_gu + (size_t)u.e * 2048 + (lane >> 5) * FF + u.pn * HALF + 4 * (lane & 31)), (LAS unsigned*)pf, 16, 0, 0);
    }
    __device__ __forceinline__ void operator()(const f32x4 (&acc)[2][2][4][2], const Unit& u, int wr, int wc, int fr, int fq, const LAS unsigned char* pf) const {
        const int row0 = u.arow0 + wr * 64 + fr, col0 = u.pn * HALF + wc * 32 + 8 * fq;
        const LAS float* bg = (const LAS float*)pf + wc * 32 + 8 * fq;
        f32x4 bgate[2], bup[2];
#pragma unroll
        for (int n = 0; n < 2; ++n) { bgate[n] = *(const LAS f32x4*)(bg + 4 * n); bup[n] = *(const LAS f32x4*)(bg + HALF + 4 * n); }
#pragma unroll
        for (int ai = 0; ai < 2; ++ai)
#pragma unroll
            for (int m = 0; m < 4; ++m) {
                float a[8];
#pragma unroll
                for (int n = 0; n < 2; ++n)
#pragma unroll
                    for (int j = 0; j < 4; ++j) {
                        const float gate = fminf(acc[ai][0][m][n][j] + bgate[n][j], 7.f), up = fminf(fmaxf(acc[ai][1][m][n][j] + bup[n][j], -7.f), 7.f);
                        a[4 * n + j] = (up + 1.f) * gate * __builtin_amdgcn_rcpf(1.f + __expf(-1.702f * gate));
                    }
                u32x4 w; w.x = cvt_pk_bf16(a[0], a[1]); w.y = cvt_pk_bf16(a[2], a[3]); w.z = cvt_pk_bf16(a[4], a[5]); w.w = cvt_pk_bf16(a[6], a[7]);
                *(u32x4*)(ACT + (size_t)(row0 + ai * HALF + m * 16) * FF + col0) = w;
            }
    }
};
struct EpiDown {
    static constexpr bool PERM = true, PREFETCH = true, MIDSCALE = false;
    bf16_t* Y; const float* b_dn; const int* sorted; const float* sortw;
    __device__ __forceinline__ void prefetch(const Unit& u, LAS unsigned char* pf, int wid, int lane) const {
        if (wid == 0) __builtin_amdgcn_global_load_lds((const unsigned*)(sorted + (size_t)u.e * TT + u.lrow0 + 4 * lane), (LAS unsigned*)pf, 16, 0, 0);
        else if (wid == 1) __builtin_amdgcn_global_load_lds((const unsigned*)(sortw + (size_t)u.e * TT + u.lrow0 + 4 * lane), (LAS unsigned*)(pf + 1024), 16, 0, 0);
        else if (wid == 2) __builtin_amdgcn_global_load_lds((const unsigned*)(b_dn + (size_t)u.e * DM + u.pn * BM + 4 * lane), (LAS unsigned*)(pf + 2048), 16, 0, 0);
    }
    __device__ __forceinline__ void operator()(const f32x4 (&acc)[2][2][4][2], const Unit& u, int wr, int wc, int fr, int fq, const LAS unsigned char* pf) const {
        const int col0 = u.pn * BM + wc * 32 + 8 * fq;
        const LAS float* bp = (const LAS float*)(pf + 2048) + wc * 32 + 8 * fq;
        f32x4 bv[2][2];
#pragma unroll
        for (int bj = 0; bj < 2; ++bj)
#pragma unroll
            for (int n = 0; n < 2; ++n) bv[bj][n] = *(const LAS f32x4*)(bp + bj * HALF + 4 * n);
        int slot[8]; float wgt[8];
#pragma unroll
        for (int q = 0; q < 8; ++q) { const int r = (q >> 2) * HALF + wr * 64 + (q & 3) * 16 + fr; slot[q] = ((const LAS int*)pf)[r]; wgt[q] = ((const LAS float*)(pf + 1024))[r]; }
#pragma unroll
        for (int ai = 0; ai < 2; ++ai)
#pragma unroll
            for (int m = 0; m < 4; ++m) {
                const int r = ai * HALF + wr * 64 + m * 16 + fr;
                if (r < u.nvalid) {
                    const float w = wgt[ai * 4 + m];
                    bf16_t* rowp = Y + (size_t)slot[ai * 4 + m] * DM + col0;
#pragma unroll
                    for (int bj = 0; bj < 2; ++bj) { const f32x4 v0 = (acc[ai][bj][m][0] + bv[bj][0]) * w, v1 = (acc[ai][bj][m][1] + bv[bj][1]) * w;
                        u32x4 o; o.x = cvt_pk_bf16(v0[0], v0[1]); o.y = cvt_pk_bf16(v0[2], v0[3]); o.z = cvt_pk_bf16(v1[0], v1[1]); o.w = cvt_pk_bf16(v1[2], v1[3]);
                        *(u32x4*)(rowp + bj * HALF) = o; }
                }
            }
    }
};

template <class Epi, class Sched, bool ALIGN_EPI>
__device__ __forceinline__ void gemm_phase(LAS unsigned char* lds, const Gemm g, const Sched& S, const Epi& E, int wid) {
    const int lane = lane_id_fresh(), tid = wid * 64 + lane, wr = wid >> 2, wc = wid & 3, fr = lane & 15, fq = lane >> 4;
    const int K = g.K, nt = K / BK;
    int RA[2], CA[2]; unsigned voffB[2];
#pragma unroll
    for (int i = 0; i < 2; ++i) { int R, C; stage_rc(tid * 16 + i * 8192, R, C); const int Rb = Epi::PERM ? ((R & ~31) + perm32(R & 31)) : R;
        RA[i] = R; CA[i] = C; voffB[i] = (unsigned)(Rb * K + C) * 2u; }
    const size_t kstep = (size_t)(BK * 2);
    const size_t hstep = (size_t)HALF * K * 2;
    const unsigned ldsw = (unsigned)wid * 1024u;
    const int aoff = lds_byte(wr * 64 + fr, fq * 8), boff = lds_byte(wc * 32 + fr, fq * 8);
#define PG8_SA(b, h) (((b) * 2 + (h)) * HTB)
#define PG8_SB(b, h) ((4 + (b) * 2 + (h)) * HTB)
#define PG8_STAGE(bufoff, gbase, voff) do { _Pragma("unroll") for (int _i = 0; _i < 2; ++_i) \
        __builtin_amdgcn_global_load_lds((const unsigned*)((const char*)(gbase) + (voff)[_i]), (LAS unsigned*)(lds + (bufoff) + ldsw + _i * 8192), 16, 0, 0); } while (0)
#define PG8_LDA(dst, b, h) do { _Pragma("unroll") for (int m = 0; m < 4; ++m) _Pragma("unroll") for (int k = 0; k < 2; ++k) dst[m][k] = *(const LAS bf16x8*)(lds + PG8_SA(b, h) + aoff + m * 2048 + k * 1024); } while (0)
#define PG8_LDB(dst, b, h) do { _Pragma("unroll") for (int n = 0; n < 2; ++n) _Pragma("unroll") for (int k = 0; k < 2; ++k) dst[n][k] = *(const LAS bf16x8*)(lds + PG8_SB(b, h) + boff + n * 2048 + k * 1024); } while (0)
#define PG8_MMA(ai, bj, At, Bt) do { __builtin_amdgcn_s_setprio(1); _Pragma("unroll") for (int m = 0; m < 4; ++m) _Pragma("unroll") for (int n = 0; n < 2; ++n) _Pragma("unroll") for (int k = 0; k < 2; ++k) \
        acc[ai][bj][m][n] = __builtin_amdgcn_mfma_f32_16x16x32_bf16(Bt[n][k], At[m][k], acc[ai][bj][m][n], 0, 0, 0); __builtin_amdgcn_s_setprio(0); } while (0)
#define PG8_WAIT_V(n) asm volatile("s_waitcnt vmcnt(" #n ")" ::: "memory")
#define PG8_WAIT_L(n) asm volatile("s_waitcnt lgkmcnt(" #n ")" ::: "memory")
#define PG8_BAR __builtin_amdgcn_s_barrier()
#define PG8_SCHED __builtin_amdgcn_sched_barrier(0)
    Unit cur, nxt; int ui = 0;
    if (!S.next(0, cur)) return;
    f32x4 acc[2][2][4][2];
#pragma unroll
    for (int a = 0; a < 2; ++a)
#pragma unroll
        for (int b = 0; b < 2; ++b)
#pragma unroll
            for (int m = 0; m < 4; ++m)
#pragma unroll
                for (int n = 0; n < 2; ++n) acc[a][b][m][n] = (f32x4){0.f, 0.f, 0.f, 0.f};
    bf16x8 At[4][2], B0[2][2], B1[2][2];
    unsigned coffA[2][2], noffA[2][2];
    S.a_off(cur, RA, CA, coffA);
    if constexpr (Epi::PREFETCH) E.prefetch(cur, lds + PF_OFF, wid, lane);
    const char* gA = (const char*)g.A; const char* cB = (const char*)g.Bt + cur.boff;
    PG8_STAGE(PG8_SB(0, 0), cB, voffB); PG8_STAGE(PG8_SB(0, 1), cB + hstep, voffB); PG8_STAGE(PG8_SA(0, 0), gA, coffA[0]); PG8_STAGE(PG8_SA(0, 1), gA, coffA[1]);
    if (wr == 1) PG8_BAR;
    PG8_WAIT_V(2); PG8_BAR;
    PG8_STAGE(PG8_SB(1, 0), cB + kstep, voffB); PG8_STAGE(PG8_SA(1, 0), gA + kstep, coffA[0]); PG8_STAGE(PG8_SB(1, 1), cB + hstep + kstep, voffB);
    PG8_WAIT_V(6); PG8_BAR;
    for (;;) {
        const bool has_next = S.next(ui + 1, nxt);
        if (has_next) S.a_off(nxt, RA, CA, noffA);
        else {
#pragma unroll
            for (int h = 0; h < 2; ++h)
#pragma unroll
                for (int i = 0; i < 2; ++i) noffA[h][i] = coffA[h][i];
        }
        const char* nB = has_next ? (const char*)g.Bt + nxt.boff : cB;
        for (int t = 0; t < nt; t += 2) {
            const bool last = (t == nt - 2);
            if constexpr (Epi::MIDSCALE) {
                if (t == nt / 2) {
                    int frx = fr; asm volatile("" : "+v"(frx));
                    const float* rb = E.rr + __builtin_amdgcn_readfirstlane(cur.arow0) + wr * 64 + frx;
#pragma unroll
                    for (int a = 0; a < 2; ++a)
#pragma unroll
                        for (int m = 0; m < 4; ++m) { const float rv = rsqrtf((rb[a * HALF + m * 16] + rb[TT + a * HALF + m * 16]) * (1.f / DM) + RMS_EPS);
#pragma unroll
                            for (int b = 0; b < 2; ++b)
#pragma unroll
                                for (int n = 0; n < 2; ++n) acc[a][b][m][n] = acc[a][b][m][n] * rv; }
                }
            }
            const char* a1 = gA + (size_t)(t + 1) * kstep;
            const char* a2 = last ? gA : gA + (size_t)(t + 2) * kstep; const char* b2 = last ? nB : cB + (size_t)(t + 2) * kstep;
            const char* a3 = a2 + kstep; const char* b3 = b2 + kstep;
            unsigned o2[2][2];
#pragma unroll
            for (int h = 0; h < 2; ++h)
#pragma unroll
                for (int i = 0; i < 2; ++i) o2[h][i] = last ? noffA[h][i] : coffA[h][i];
            PG8_LDB(B0, 0, 0); PG8_LDB(B1, 0, 1); PG8_SCHED; PG8_LDA(At, 0, 0); PG8_STAGE(PG8_SA(1, 1), a1, coffA[1]);
            PG8_WAIT_V(8); PG8_WAIT_L(0); PG8_BAR; PG8_MMA(0, 0, At, B0); PG8_MMA(0, 1, At, B1); PG8_BAR; PG8_SCHED;
            PG8_LDA(At, 0, 1); PG8_STAGE(PG8_SB(0, 0), b2, voffB); PG8_STAGE(PG8_SB(0, 1), b2 + hstep, voffB); PG8_STAGE(PG8_SA(0, 0), a2, o2[0]);
            PG8_WAIT_V(8); PG8_WAIT_L(0); PG8_BAR; PG8_MMA(1, 0, At, B0); PG8_MMA(1, 1, At, B1); PG8_BAR; PG8_SCHED;
            PG8_LDB(B0, 1, 0); PG8_LDB(B1, 1, 1); PG8_SCHED; PG8_LDA(At, 1, 0); PG8_STAGE(PG8_SA(0, 1), a2, o2[1]);
            PG8_WAIT_V(8); PG8_WAIT_L(0); PG8_BAR; PG8_MMA(0, 0, At, B0); PG8_MMA(0, 1, At, B1); PG8_BAR; PG8_SCHED;
            PG8_LDA(At, 1, 1); PG8_STAGE(PG8_SB(1, 0), b3, voffB); PG8_STAGE(PG8_SB(1, 1), b3 + hstep, voffB); PG8_STAGE(PG8_SA(1, 0), a3, o2[0]);
            PG8_WAIT_V(8); PG8_WAIT_L(0); PG8_BAR; PG8_MMA(1, 0, At, B0); PG8_MMA(1, 1, At, B1); PG8_BAR; PG8_SCHED;
        }
        if constexpr (ALIGN_EPI) { if (wr == 0) PG8_BAR; }
        if constexpr (Epi::PREFETCH) { if (has_next) E.prefetch(nxt, lds + PF_OFF + ((ui + 1) & 1) * PF_BYTES, wid, lane); }
        E(acc, cur, wr, wc, fr, fq, lds + PF_OFF + (ui & 1) * PF_BYTES);
        if (!has_next) break;
#pragma unroll
        for (int a = 0; a < 2; ++a)
#pragma unroll
            for (int b = 0; b < 2; ++b)
#pragma unroll
                for (int m = 0; m < 4; ++m)
#pragma unroll
                    for (int n = 0; n < 2; ++n) acc[a][b][m][n] = (f32x4){0.f, 0.f, 0.f, 0.f};
        cur = nxt; cB = nB; ++ui;
#pragma unroll
        for (int h = 0; h < 2; ++h)
#pragma unroll
            for (int i = 0; i < 2; ++i) coffA[h][i] = noffA[h][i];
        if constexpr (ALIGN_EPI) { if (wr == 1) PG8_BAR; }
    }
    PG8_WAIT_V(0);
    if constexpr (!ALIGN_EPI) { if (wr == 0) PG8_BAR; }
    PG8_BAR;
#undef PG8_SA
#undef PG8_SB
#undef PG8_STAGE
#undef PG8_LDA
#undef PG8_LDB
#undef PG8_MMA
#undef PG8_WAIT_V
#undef PG8_WAIT_L
#undef PG8_BAR
#undef PG8_SCHED
}
}

#define XB_TMO      128
#define XB_XCNT(j)  (256  + 64 * (j))
#define XB_XSUB(j)  (1280 + 64 * (j))
#define XB_XGEN(j)  (2304 + 64 * (j))
#define XB_TOP      3328
#define XB_TOPGEN   3392
#define XCD_BAR_WORDS 3456
#define XB_SPIN_CAP (1u << 18)
__device__ __forceinline__ unsigned xb_ld(unsigned* p)              { return __hip_atomic_load(p, __ATOMIC_RELAXED, __HIP_MEMORY_SCOPE_AGENT); }
__device__ __forceinline__ unsigned xb_add(unsigned* p, unsigned v) { return __hip_atomic_fetch_add(p, v, __ATOMIC_RELAXED, __HIP_MEMORY_SCOPE_AGENT); }
__device__ __forceinline__ unsigned xb_xcc_id() { return (unsigned)__builtin_amdgcn_s_getreg((3 << 11) | 20) & 0xFu; }
#define XB_SPIN(cond, bar) do { unsigned _sp = 0; while (cond) { __builtin_amdgcn_s_sleep(1); \
    if ((++_sp & 255u) == 0u) { if (xb_ld(&(bar)[XB_TMO])) break; if (_sp > XB_SPIN_CAP) { atomicAdd(&(bar)[XB_TMO], 1u); break; } } } } while (0)
struct XcdBarrier { unsigned* bar; unsigned x; volatile LAS unsigned* st; };
__device__ __forceinline__ XcdBarrier xcd_barrier_post(unsigned* bar, volatile LAS unsigned* st) {
    XcdBarrier b; b.bar = bar; b.x = xb_xcc_id(); b.st = st;
    if (threadIdx.x == 0) (void)xb_add(&bar[XB_XCNT(b.x)], 1u);
    return b;
}
__device__ __forceinline__ void xcd_barrier_complete(unsigned* bar, unsigned x, unsigned& nloc, unsigned& nx) {
    const unsigned G = gridDim.x * gridDim.y * gridDim.z;
    unsigned sum, cnt, mine, sp = 0u;
    for (;;) {
        sum = 0u; cnt = 0u; mine = 0u;
#pragma unroll
        for (unsigned j = 0; j < 16; ++j) { const unsigned c = xb_ld(&bar[XB_XCNT(j)]); sum += c; cnt += (c > 0u) ? 1u : 0u; mine = (j == x) ? c : mine; }
        if (sum == G) break;
        __builtin_amdgcn_s_sleep(1);
        if ((++sp & 255u) == 0u) { if (xb_ld(&bar[XB_TMO])) break; if (sp > XB_SPIN_CAP) { atomicAdd(&bar[XB_TMO], 1u); break; } }
    }
    nloc = mine > 0u ? mine : 1u; nx = cnt > 0u ? cnt : 1u;
}
__device__ __forceinline__ void xcd_barrier(const XcdBarrier& b, int wave) {
    asm volatile("s_waitcnt vmcnt(0)" ::: "memory");
    __syncthreads();
    if (wave == 0 && lane_id_fresh() == 0) {
        unsigned* bar = b.bar;
        __builtin_amdgcn_s_waitcnt(0);
        unsigned nloc = b.st[0], nx = b.st[1];
        if (nloc == 0u) { xcd_barrier_complete(bar, b.x, nloc, nx); b.st[0] = nloc; b.st[1] = nx; }
        const unsigned old = xb_add(&bar[XB_XSUB(b.x)], 1u);
        const unsigned gen = old / nloc;
        if (old + 1u == (gen + 1u) * nloc) {
            __builtin_amdgcn_fence(__ATOMIC_RELEASE, "agent");
            asm volatile("s_waitcnt vmcnt(0)" ::: "memory");
            const unsigned og = xb_add(&bar[XB_TOP], 1u);
            const unsigned tg = og / nx;
            if (og + 1u == (tg + 1u) * nx) xb_add(&bar[XB_TOPGEN], 1u);
            else XB_SPIN(xb_ld(&bar[XB_TOPGEN]) == tg, bar);
            __builtin_amdgcn_fence(__ATOMIC_ACQUIRE, "agent");
            xb_add(&bar[XB_XGEN(b.x)], 1u);
            asm volatile("s_waitcnt vmcnt(0)" ::: "memory");
        } else {
            XB_SPIN(xb_ld(&bar[XB_XGEN(b.x)]) == gen, bar);
            __builtin_amdgcn_fence(__ATOMIC_ACQUIRE, "agent");
            asm volatile("s_waitcnt vmcnt(0)" ::: "memory");
        }
    }
    __syncthreads();
}

struct Ctx {
    LAS unsigned char* lds; int wave, G, bid;
    const float *x, *c, *w_ada, *b_ada, *g_pre_mix, *g_post_mix, *w_in, *conv_w, *conv_b, *dt_bias, *a_log, *d_skip, *g_ssd, *w_out, *g_pre_ffn, *g_post_ffn, *w_router, *b_router, *w_gu, *b_gu, *w_dn, *b_dn;
    float* out; unsigned* ctl; float* mod;
    bf16_t *WIN, *WOUT, *WGU, *WDN, *H, *PROJ, *XC, *MIXIN, *ACT, *YSLOT;
    float *DT, *TOPW, *CUM, *CHDEC, *LSE, *SORTW, *RR; int* SORT; bf16_t *STATES, *OPART, *HPREV, *WRT, *MIX, *RES;
};

struct P0Item { const float* src; bf16_t* dst; int N, K, gu; };
__device__ __forceinline__ void p0_load(const P0Item& d, int lane, f32x4 (&v)[8]) {
    const float* p = d.src + (size_t)(lane >> 3) * d.N + 4 * (lane & 7);
#pragma unroll
    for (int j = 0; j < 8; ++j) v[j] = *(const f32x4*)(p + (size_t)(8 * j) * d.N);
}
__device__ __forceinline__ void p0_emit(const P0Item& d, int n0, int lane, LAS float* scr, const f32x4 (&v)[8]) {
    LAS float* w = scr + (lane >> 3) * 33 + 4 * (lane & 7);
#pragma unroll
    for (int j = 0; j < 8; ++j) { w[(8 * j) * 33] = v[j].x; w[(8 * j) * 33 + 1] = v[j].y; w[(8 * j) * 33 + 2] = v[j].z; w[(8 * j) * 33 + 3] = v[j].w; }
    LDS_WAIT(); asm volatile("" ::: "memory");
    const int c = lane & 7;
#pragma unroll
    for (int j = 0; j < 4; ++j) { const int n = (lane >> 3) + 8 * j; const LAS float* s = scr + (8 * c) * 33 + n;
        u32x4 o; o.x = pk2(s[0 * 33], s[1 * 33]); o.y = pk2(s[2 * 33], s[3 * 33]); o.z = pk2(s[4 * 33], s[5 * 33]); o.w = pk2(s[6 * 33], s[7 * 33]);
        int row = n;
        if (d.gu) { const int g = n0 + n, jj = g < FF ? g : g - FF; row = (jj >> 7) * 256 + (g < FF ? 0 : 128) + (jj & 127) - n0; }
        *(GAS u32x4*)(d.dst + (ptrdiff_t)row * d.K + 8 * c) = o; }
    LDS_WAIT(); asm volatile("" ::: "memory");
}

__device__ __forceinline__ void p0_prologue(const Ctx& F) {
    const int f_lane = lane_id_fresh();
    {
        LAS float* red = (LAS float*)(F.lds);
        for (int it = F.bid; it < 96; it += F.G) {
            const int col = it * 64 + f_lane; float a0 = 0.f, a1 = 0.f;
#pragma unroll 16
            for (int k = F.wave * 128; k < F.wave * 128 + 128; ++k) { const float w = F.w_ada[(size_t)k * 6144 + col]; a0 += siluf(F.c[k]) * w; a1 += siluf(F.c[DM + k]) * w; }
            red[(F.wave * 2 + 0) * 64 + f_lane] = a0; red[(F.wave * 2 + 1) * 64 + f_lane] = a1;
            __syncthreads();
            if (F.wave < 2) { float s = F.b_ada[col];
#pragma unroll
                for (int w = 0; w < 8; ++w) s += red[(w * 2 + F.wave) * 64 + f_lane];
                F.mod[F.wave * 6144 + col] = s; }
            asm volatile("s_waitcnt vmcnt(0)" ::: "memory");
            __syncthreads();
            if (F.wave == 0 && f_lane == 0) {
                __builtin_amdgcn_fence(__ATOMIC_RELEASE, "agent"); asm volatile("s_waitcnt vmcnt(0)" ::: "memory");
                __hip_atomic_fetch_add(F.ctl + CW_MODCNT, 1u, __ATOMIC_RELAXED, __HIP_MEMORY_SCOPE_AGENT); }
        }
    }
    for (int i = F.bid * NTHREADS + F.wave * 64 + f_lane; i < DM * NEXP; i += F.G * NTHREADS) { const int k = i >> 5, e = i & 31; const float w = F.w_router[i];
        const bf16_t hi = f2bf(w); F.WRT[e * DM + k] = hi; F.WRT[NEXP * DM + e * DM + k] = f2bf(w - bf2f(hi)); }
    LAS float* scr = (LAS float*)(F.lds + F.wave * 16384);
    const int gw = F.bid * NWAVES + F.wave, NGW = F.G * NWAVES;
    constexpr int I_IN = (DM / 64) * (NPROJ_ALL / 32), I_OUT = (2048 / 64) * (DM / 32);
    constexpr int NITEMS = I_IN + I_OUT;
    auto desc = [&](int it, P0Item& d, int& n0) {
        int r = it; const float* W; bf16_t* WT; int K, N; d.gu = 0;
        if (r < I_IN) { W = F.w_in; WT = F.WIN; K = DM; N = NPROJ_ALL; }
        else { r -= I_IN; W = F.w_out; WT = F.WOUT; K = 2048; N = DM; }
        const int nblk = N / 32, kb = r / nblk, nb = r - kb * nblk; n0 = 32 * nb;
        const int kd = (W == F.w_out) ? ((kb + 16) & 31) : kb;
        d.src = W + (size_t)(64 * kb) * N + n0; d.dst = WT + (size_t)n0 * K + 64 * kd; d.N = N; d.K = K;
    };
    f32x4 va[8]; P0Item da; int na = 0;
    for (int it = gw; it < NITEMS; it += NGW) { desc(it, da, na); p0_load(da, f_lane, va); p0_emit(da, na, f_lane, scr, va); }
}

constexpr int FI_GU = (DM / 64) * (2048 / 32), FI_DN = (FF / 64) * (DM / 32), FILL_GU = NEXP * FI_GU, FILL_ALL = NEXP * (FI_GU + FI_DN);
__device__ __forceinline__ void merge_token(const Ctx& F, int t, int lane) {
    const int hd = lane >> 2;
    const float l0 = F.LSE[(size_t)t * 16 + hd], l1 = F.LSE[((size_t)TT + t) * 16 + hd], l2 = F.LSE[((size_t)2 * TT + t) * 16 + hd];
    u32x4 v[3][2];
#pragma unroll
    for (int g = 0; g < 3; ++g) { const bf16_t* src = F.OPART + ((size_t)g * TT + t) * DM + 16 * lane; v[g][0] = *(const u32x4*)src; v[g][1] = *(const u32x4*)(src + 8); }
    const float m = fmaxf(l0, fmaxf(l1, l2)), e0 = __builtin_amdgcn_exp2f(l0 - m), e1 = __builtin_amdgcn_exp2f(l1 - m), e2 = __builtin_amdgcn_exp2f(l2 - m), inv = 1.f / (e0 + e1 + e2);
    const float w[3] = {e0 * inv, e1 * inv, e2 * inv};
#pragma unroll
    for (int hv = 0; hv < 2; ++hv) { float a[8] = {0.f, 0.f, 0.f, 0.f, 0.f, 0.f, 0.f, 0.f};
#pragma unroll
        for (int g = 0; g < 3; ++g) { const u32x4 q = v[g][hv];
            a[0] += w[g] * __uint_as_float(q.x << 16); a[1] += w[g] * __uint_as_float(q.x & 0xffff0000u); a[2] += w[g] * __uint_as_float(q.y << 16); a[3] += w[g] * __uint_as_float(q.y & 0xffff0000u);
            a[4] += w[g] * __uint_as_float(q.z << 16); a[5] += w[g] * __uint_as_float(q.z & 0xffff0000u); a[6] += w[g] * __uint_as_float(q.w << 16); a[7] += w[g] * __uint_as_float(q.w & 0xffff0000u); }
        u32x4 o; o.x = pk2(a[0], a[1]); o.y = pk2(a[2], a[3]); o.z = pk2(a[4], a[5]); o.w = pk2(a[6], a[7]);
        *(u32x4*)(F.MIXIN + (size_t)t * 2048 + 1024 + 16 * lane + 8 * hv) = o; }
}
constexpr int FQ_GU = FILL_GU / NWAVES, FQ_ALL = FILL_ALL / NWAVES, MQ_ALL = TT / (2 * NWAVES);
struct Fill { int pend, mpend, mopen, wdone, mdone; };
__device__ __forceinline__ void merge_item(const Ctx& F, int it) {
    const int lane = lane_id_fresh(), t = (it * NWAVES + F.wave) * 2;
    merge_token(F, t, lane); merge_token(F, t + 1, lane);
}
__device__ __forceinline__ void fill_item(const Ctx& F, int it) {
    const int lane = lane_id_fresh(); int r = it * NWAVES + F.wave;
    P0Item d; const float* W; bf16_t* WT; int K, N;
    if (r < FILL_GU) { const int e = r / FI_GU; r -= e * FI_GU; W = F.w_gu + (size_t)e * DM * 2048; WT = F.WGU + (size_t)e * 2048 * DM; K = DM; N = 2048; d.gu = 1; }
    else { r -= FILL_GU; const int e = r / FI_DN; r -= e * FI_DN; W = F.w_dn + (size_t)e * FF * DM; WT = F.WDN + (size_t)e * DM * FF; K = FF; N = DM; d.gu = 0; }
    const int nblk = N / 32, kb = r / nblk, nb = r - kb * nblk, n0 = 32 * nb;
    d.src = W + (size_t)(64 * kb) * N + n0; d.dst = WT + (size_t)n0 * K + 64 * kb; d.N = N; d.K = K;
    f32x4 v[8]; p0_load(d, lane, v); p0_emit(d, n0, lane, (LAS float*)(F.lds + F.wave * 16384), v);
}
__device__ __forceinline__ int fill_want(const Fill& fs) { if (fs.pend >= 0 || fs.mpend >= 0) return 0; if (fs.mopen && !fs.mdone) return 2; return fs.wdone ? 0 : 1; }
__device__ __forceinline__ void fill_take(Fill& fs, int want, int v) {
    if (want == 2) { if (v >= MQ_ALL) fs.mdone = 1; else fs.mpend = v; } else if (want == 1) { if (v >= FQ_ALL) fs.wdone = 1; else fs.pend = v; }
}
__device__ __forceinline__ void fill_drain(const Ctx& F, Fill& fs, int which, int limit, volatile LAS unsigned* W) {
    const bool t0 = (F.wave == 0 && lane_id_fresh() == 0);
    for (;;) {
        if (which == 2) { if (fs.mpend >= 0) { merge_item(F, fs.mpend); fs.mpend = -1; } if (fs.mdone) break; }
        else { if (fs.pend >= 0) { if (fs.pend >= limit) break; fill_item(F, fs.pend); fs.pend = -1; } if (fs.wdone) break; }
        __syncthreads();
        if (t0) W[5] = (unsigned)__hip_atomic_fetch_add(F.ctl + (which == 2 ? CW_MQ : CW_FQ), 1u, __ATOMIC_RELAXED, __HIP_MEMORY_SCOPE_AGENT);
        __syncthreads();
        fill_take(fs, which, (int)W[5]);
    }
}
__device__ __forceinline__ void xcd_barrier_fill(const XcdBarrier& b, const Ctx& F, Fill& fs) {
    asm volatile("s_waitcnt vmcnt(0)" ::: "memory");
    __syncthreads();
    const bool t0 = (F.wave == 0 && lane_id_fresh() == 0);
    volatile LAS unsigned* W = b.st;
    unsigned* bar = b.bar;
    if (t0) {
        __builtin_amdgcn_s_waitcnt(0);
        unsigned nloc = W[0], nx = W[1];
        if (nloc == 0u) { xcd_barrier_complete(bar, b.x, nloc, nx); W[0] = nloc; W[1] = nx; }
        const unsigned old = xb_add(&bar[XB_XSUB(b.x)], 1u), gen = old / nloc;
        unsigned role = 0u, val = gen;
        if (old + 1u == (gen + 1u) * nloc) {
            __builtin_amdgcn_fence(__ATOMIC_RELEASE, "agent");
            asm volatile("s_waitcnt vmcnt(0)" ::: "memory");
            const unsigned og = xb_add(&bar[XB_TOP], 1u), tg = og / nx;
            role = 1u; val = tg;
            if (og + 1u == (tg + 1u) * nx) { xb_add(&bar[XB_TOPGEN], 1u); role = 3u; }
        }
        W[2] = role; W[3] = val; W[4] = 0u;
    }
    for (unsigned it = 0;; ++it) {
        __syncthreads();
        if (t0) {
            const unsigned role = W[2], val = W[3]; bool done;
            const int want = fill_want(fs);
            if (want) W[5] = (unsigned)__hip_atomic_fetch_add(F.ctl + (want == 2 ? CW_MQ : CW_FQ), 1u, __ATOMIC_RELAXED, __HIP_MEMORY_SCOPE_AGENT);
            if (role & 1u) done = (role & 2u) || (xb_ld(&bar[XB_TOPGEN]) != val); else done = (xb_ld(&bar[XB_XGEN(b.x)]) != val);
            if (!done && (it & 15u) == 15u) { if (xb_ld(&bar[XB_TMO])) done = true; else if (it > (1u << 16)) { atomicAdd(&bar[XB_TMO], 1u); done = true; } }
            if (done) { __builtin_amdgcn_fence(__ATOMIC_ACQUIRE, "agent"); if (role & 1u) xb_add(&bar[XB_XGEN(b.x)], 1u); }
            W[4] = done ? 1u : 0u;
        }
        __syncthreads();
        { const int want = fill_want(fs); if (want) fill_take(fs, want, (int)W[5]); }
        if (W[4]) break;
        if (fs.mpend >= 0) { merge_item(F, fs.mpend); fs.mpend = -1; } else if (fs.pend >= 0) { fill_item(F, fs.pend); fs.pend = -1; } else __builtin_amdgcn_s_sleep(4);
    }
    if (t0) asm volatile("s_waitcnt vmcnt(0)" ::: "memory");
    __syncthreads();
}

__device__ __forceinline__ void p1_prenorm(const Ctx& F) {
    const int gw = F.bid * NWAVES + F.wave, NGW = F.G * NWAVES, lane = lane_id_fresh();
    if (F.wave == 0 && lane == 0) {
        const unsigned need = (unsigned)min(96, F.G > 96 ? 96 : 96);
        unsigned sp = 0; while (__hip_atomic_load(F.ctl + CW_MODCNT, __ATOMIC_RELAXED, __HIP_MEMORY_SCOPE_AGENT) < need) { __builtin_amdgcn_s_sleep(2); if (++sp > (1u << 20)) break; }
        __builtin_amdgcn_fence(__ATOMIC_ACQUIRE, "agent"); asm volatile("s_waitcnt vmcnt(0)" ::: "memory"); }
    __syncthreads();
    f32x4 vn[2][4];
#define P1_LOAD(t0_) do { const int ta_ = (t0_), tb_ = (t0_) + NGW < TT ? (t0_) + NGW : (t0_); _Pragma("unroll") for (int j = 0; j < 4; ++j) { \
        vn[0][j] = *(const f32x4*)(F.x + (size_t)ta_ * DM + 4 * lane + 256 * j); vn[1][j] = *(const f32x4*)(F.x + (size_t)tb_ * DM + 4 * lane + 256 * j); } } while (0)
    if (gw < TT) P1_LOAD(gw);
    for (int t0 = gw; t0 < TT; t0 += 2 * NGW) {
        const int tt[2] = {t0, t0 + NGW < TT ? t0 + NGW : t0};
        f32x4 v[2][4]; float ss[2] = {0.f, 0.f};
#pragma unroll
        for (int q = 0; q < 2; ++q)
#pragma unroll
            for (int j = 0; j < 4; ++j) v[q][j] = vn[q][j];
        f32x4 ga[2][4], sh[2][4];
#pragma unroll
        for (int q = 0; q < 2; ++q) { const float* shift = F.mod + (tt[q] / SEQ) * 6144; const float* scale = shift + 1024;
#pragma unroll
            for (int j = 0; j < 4; ++j) { const int k = 4 * lane + 256 * j; if (q == 0 || tt[1] / SEQ != tt[0] / SEQ) { ga[q][j] = *(const f32x4*)(F.g_pre_mix + k) * (*(const f32x4*)(scale + k) + 1.f); sh[q][j] = *(const f32x4*)(shift + k); } else { ga[q][j] = ga[0][j]; sh[q][j] = sh[0][j]; } } }
        if (t0 + 2 * NGW < TT) P1_LOAD(t0 + 2 * NGW);
#pragma unroll
        for (int q = 0; q < 2; ++q)
#pragma unroll
            for (int j = 0; j < 4; ++j) ss[q] += v[q][j].x * v[q][j].x + v[q][j].y * v[q][j].y + v[q][j].z * v[q][j].z + v[q][j].w * v[q][j].w;
#pragma unroll
        for (int q = 0; q < 2; ++q) {
            const int t = tt[q];
            const float r = rsqrtf(wave_sum(ss[q]) * (1.f / DM) + RMS_EPS);
#pragma unroll
            for (int j = 0; j < 4; ++j) {
                const int k = 4 * lane + 256 * j;
                const f32x4 h = v[q][j] * r * ga[q][j] + sh[q][j];
                u32x2 o; o.x = pk2(h.x, h.y); o.y = pk2(h.z, h.w);
                *(u32x2*)(F.H + (size_t)t * DM + k) = o;
            }
        }
    }
#undef P1_LOAD
}
typedef short s16x4 __attribute__((ext_vector_type(4)));
typedef short v4i16_t __attribute__((ext_vector_type(4)));
__device__ __forceinline__ s16x4 tr_read(const LAS unsigned char* p) { return __builtin_bit_cast(s16x4, __builtin_amdgcn_ds_read_tr16_b64_v4i16((LAS v4i16_t*)p)); }
template <int OFF> __device__ __forceinline__ u32x2 tr_read_a(unsigned addr) { u32x2 r; asm volatile("ds_read_b64_tr_b16 %0, %1 offset:%2" : "=v"(r) : "v"(addr), "n"(OFF) : "memory"); return r; }
template <int OFF> __device__ __forceinline__ u32x4 lds_read_a(unsigned addr) { u32x4 r; asm volatile("ds_read_b128 %0, %1 offset:%2" : "=v"(r) : "v"(addr), "n"(OFF) : "memory"); return r; }
__device__ __forceinline__ void lds_wait4(u32x4 (&t)[4]) { asm volatile("s_waitcnt lgkmcnt(0)" : "+v"(t[0]), "+v"(t[1]), "+v"(t[2]), "+v"(t[3]) :: "memory"); }
__device__ __forceinline__ void tr_wait8(u32x2 (&t)[8]) { asm volatile("s_waitcnt lgkmcnt(0)" : "+v"(t[0]), "+v"(t[1]), "+v"(t[2]), "+v"(t[3]), "+v"(t[4]), "+v"(t[5]), "+v"(t[6]), "+v"(t[7]) :: "memory"); }
__device__ __forceinline__ bf16x8 cat8(s16x4 a, s16x4 b) { return (bf16x8){a[0], a[1], a[2], a[3], b[0], b[1], b[2], b[3]}; }
__device__ __forceinline__ unsigned cvtpk(float lo, float hi) { return pg8::cvt_pk_bf16(lo, hi); }
constexpr float LOG2E = 1.4426950408889634f;
__device__ __forceinline__ void p3_attention(const Ctx& F) {
    const int lane = lane_id_fresh(), wave = F.wave, tid = wave * 64 + lane, fr = lane & 15, fq = lane >> 4;
    LAS unsigned char* KIMG = F.lds;
    LAS unsigned char* VIMG = F.lds + 49152;
    const int vcu = (F.G % 8 == 0) ? (F.bid % 8) * (F.G / 8) + F.bid / 8 : F.bid;
    constexpr int NU = 2 * 16 * 3 * 32;
    const int per = (NU + F.G - 1) / F.G, u0 = vcu * per, u1 = min(NU, u0 + per);
    const int rsub = tid >> 3, c8 = tid & 7;
    LAS unsigned char* kst = KIMG + rsub * 128 + ((c8 ^ (rsub & 7)) << 4);
    LAS unsigned char* vst = VIMG + rsub * 128 + (((c8 >> 1) ^ ((rsub >> 1) & 3)) << 5) + (c8 & 1) * 16;
    u32x4 kr[6], vr[6]; bf16x8 qn_[2][2];
#define ATT_DECODE(u) const int bh_ = (u) / 96, rem_ = (u) % 96, g_ = rem_ >> 5, blk_ = rem_ & 31, sh_ = 2 * g_  , d_ = 1 << sh_, bpr_ = 32 >> sh_, \
        r_ = blk_ / bpr_, n0_ = (blk_ % bpr_) * 256, b_ = bh_ >> 4, h_ = bh_ & 15, Ls_ = SEQ >> sh_
#define ATT_LOAD_KV(u) do { ATT_DECODE(u); _Pragma("unroll") for (int i = 0; i < 6; ++i) { const int row = rsub + 64 * i, n = n0_ - 64 + row; \
            const bool ok = (n >= 0) && (n < Ls_); const bf16_t* src = F.PROJ + ((size_t)b_ * SEQ + (size_t)(ok ? n : 0) * d_ + r_) * NPROJ + h_ * 64 + c8 * 8; \
            kr[i] = ok ? *(const u32x4*)(src + C_K) : (u32x4){0u, 0u, 0u, 0u}; vr[i] = ok ? *(const u32x4*)(src + C_V) : (u32x4){0u, 0u, 0u, 0u}; } } while (0)
#define ATT_LOAD_Q(u) do { ATT_DECODE(u); _Pragma("unroll") for (int qt = 0; qt < 2; ++qt) { \
            const bf16_t* qp = F.PROJ + ((size_t)b_ * SEQ + (size_t)(n0_ + 32 * wave + 16 * qt + fr) * d_ + r_) * NPROJ + C_Q + h_ * 64 + 8 * fq; qn_[qt][0] = *(const bf16x8*)qp; qn_[qt][1] = *(const bf16x8*)(qp + 32); } } while (0)
    if (u0 < u1) { ATT_LOAD_KV(u0); } if (u0 < u1) { ATT_LOAD_Q(u0); }
    const int rq = (lane & 15) >> 2, cq = lane & 3, rl = 4 * fq + rq, xsw = (rl >> 1) & 3;
    const LAS unsigned char* vrow = VIMG + (32 * wave + rl) * 128 + cq * 8;
    const LAS unsigned char* krow = KIMG + (32 * wave + fr) * 128;
    const int jbase = 4 * fq - 64 - fr;
    float nb[9][4];
#pragma unroll
    for (int t = 0; t < 9; ++t)
#pragma unroll
        for (int i = 0; i < 4; ++i) { const int j = 16 * t + i + jbase, aj = j < 0 ? -j : j; nb[t][i] = (aj <= 64) ? -(float)aj : -1e30f; }
#pragma unroll 1
    for (int u = u0; u < u1; ++u) {
        __syncthreads();
#pragma unroll
        for (int i = 0; i < 6; ++i) { *(LAS u32x4*)(kst + i * 64 * 128) = kr[i]; *(LAS u32x4*)(vst + i * 64 * 128) = vr[i]; }
        __syncthreads();
        if (u + 1 < u1) ATT_LOAD_KV(u + 1);
        ATT_DECODE(u);
        const float slope2 = exp2f(-0.5f * (float)(h_ + 1)) * LOG2E * (float)d_;
        f32x4 s[2][9];
#pragma unroll
        for (int t = 0; t < 10; ++t) {
            bf16x8 kf[2];
#pragma unroll
            for (int ks = 0; ks < 2; ++ks) kf[ks] = *(const LAS bf16x8*)(krow + (16 * t) * 128 + (((4 * ks + fq) ^ (fr & 7)) << 4));
#pragma unroll
            for (int qt = 0; qt < 2; ++qt) { const int tp = t - qt; if (tp >= 0 && tp < 9) { f32x4 a = (f32x4){0.f, 0.f, 0.f, 0.f};
                a = __builtin_amdgcn_mfma_f32_16x16x32_bf16(kf[0], qn_[qt][0], a, 0, 0, 0); a = __builtin_amdgcn_mfma_f32_16x16x32_bf16(kf[1], qn_[qt][1], a, 0, 0, 0); s[qt][tp] = a; } }
        }
        if (u + 1 < u1) ATT_LOAD_Q(u + 1);
#pragma unroll
        for (int qt = 0; qt < 2; ++qt)
#pragma unroll
            for (int t = 0; t < 9; ++t)
#pragma unroll
                for (int i = 0; i < 4; ++i) s[qt][t][i] = s[qt][t][i] + slope2 * nb[t][i];
        if (n0_ == 0 || n0_ + 320 > Ls_) {
#pragma unroll
            for (int qt = 0; qt < 2; ++qt) { const int qn = n0_ + 32 * wave + 16 * qt + fr;
#pragma unroll
                for (int t = 0; t < 9; ++t)
#pragma unroll
                    for (int i = 0; i < 4; ++i) { const int j = 16 * t + i + jbase; if ((unsigned)(qn + j) >= (unsigned)Ls_) s[qt][t][i] = -1e30f; } }
        }
        float mx[2], lsum[2];
#pragma unroll
        for (int qt = 0; qt < 2; ++qt) { float m = -1e30f;
#pragma unroll
            for (int t = 0; t < 9; ++t) { asm("v_max3_f32 %0, %0, %1, %2" : "+v"(m) : "v"(s[qt][t][0]), "v"(s[qt][t][1])); asm("v_max3_f32 %0, %0, %1, %2" : "+v"(m) : "v"(s[qt][t][2]), "v"(s[qt][t][3])); }
            { const float m1 = __shfl_xor(m, 16); asm("v_max_f32 %0, %0, %1" : "+v"(m) : "v"(m1)); const float m2 = __shfl_xor(m, 32); asm("v_max_f32 %0, %0, %1" : "+v"(m) : "v"(m2)); } mx[qt] = m;
#pragma unroll
            for (int t = 0; t < 9; ++t)
#pragma unroll
                for (int i = 0; i < 4; ++i) s[qt][t][i] = __builtin_amdgcn_exp2f(s[qt][t][i] - m); }
        f32x4 o[2][4], osum[2];
        const bf16x8 ones = __builtin_bit_cast(bf16x8, (u32x4){0x3f803f80u, 0x3f803f80u, 0x3f803f80u, 0x3f803f80u});
#pragma unroll
        for (int qt = 0; qt < 2; ++qt) { osum[qt] = (f32x4){0.f, 0.f, 0.f, 0.f};
#pragma unroll
            for (int dt = 0; dt < 4; ++dt) o[qt][dt] = (f32x4){0.f, 0.f, 0.f, 0.f}; }
#pragma unroll
        for (int kk = 0; kk < 5; ++kk) {
            bf16x8 pop[2];
#pragma unroll
            for (int qt = 0; qt < 2; ++qt) { const int ta = 2 * kk - qt, tb = 2 * kk + 1 - qt; u32x4 pw = (u32x4){0u, 0u, 0u, 0u};
                if (ta >= 0 && ta < 9) { pw.x = cvtpk(s[qt][ta][0], s[qt][ta][1]); pw.y = cvtpk(s[qt][ta][2], s[qt][ta][3]); }
                if (tb >= 0 && tb < 9) { pw.z = cvtpk(s[qt][tb][0], s[qt][tb][1]); pw.w = cvtpk(s[qt][tb][2], s[qt][tb][3]); }
                pop[qt] = __builtin_bit_cast(bf16x8, pw); osum[qt] = __builtin_amdgcn_mfma_f32_16x16x32_bf16(ones, pop[qt], osum[qt], 0, 0, 0); }
#pragma unroll
            for (int dt = 0; dt < 4; ++dt) { const LAS unsigned char* vp = vrow + ((dt ^ xsw) << 5);
                const bf16x8 va = cat8(tr_read(vp + (32 * kk) * 128), tr_read(vp + (32 * kk + 16) * 128));
#pragma unroll
                for (int qt = 0; qt < 2; ++qt) o[qt][dt] = __builtin_amdgcn_mfma_f32_16x16x32_bf16(va, pop[qt], o[qt][dt], 0, 0, 0); }
        }
#pragma unroll
        for (int qt = 0; qt < 2; ++qt) {
            const int qn = n0_ + 32 * wave + 16 * qt + fr; const size_t tokq = (size_t)b_ * SEQ + (size_t)qn * d_ + r_;
            lsum[qt] = osum[qt][0];
            const float inv = __builtin_amdgcn_rcpf(lsum[qt]);
            bf16_t* op = F.OPART + ((size_t)g_ * TT + tokq) * DM + h_ * 64 + 4 * fq;
#pragma unroll
            for (int dt = 0; dt < 4; ++dt) { u32x2 w; w.x = cvtpk(o[qt][dt][0] * inv, o[qt][dt][1] * inv); w.y = cvtpk(o[qt][dt][2] * inv, o[qt][dt][3] * inv); *(u32x2*)(op + 16 * dt) = w; }
            if (fq == 0) F.LSE[((size_t)g_ * TT + tokq) * 16 + h_] = mx[qt] + log2f(lsum[qt]);
        }
    }
#undef ATT_LOAD_KV
#undef ATT_LOAD_Q
#undef ATT_DECODE
}
__device__ __forceinline__ void p4_attn_merge(const Ctx& F) {
    const int gw = F.bid * NWAVES + F.wave, NGW = F.G * NWAVES, lane = lane_id_fresh(), hd = lane >> 2;
#pragma unroll 2
    for (int t = gw; t < TT; t += NGW) {
        const float l0 = F.LSE[(size_t)t * 16 + hd], l1 = F.LSE[((size_t)TT + t) * 16 + hd], l2 = F.LSE[((size_t)2 * TT + t) * 16 + hd];
        const float m = fmaxf(l0, fmaxf(l1, l2)), e0 = exp2f(l0 - m), e1 = exp2f(l1 - m), e2 = exp2f(l2 - m), inv = 1.f / (e0 + e1 + e2);
        const float w[3] = {e0 * inv, e1 * inv, e2 * inv};
        float acc[16];
#pragma unroll
        for (int i = 0; i < 16; ++i) acc[i] = 0.f;
#pragma unroll
        for (int g = 0; g < 3; ++g) { const bf16_t* src = F.OPART + ((size_t)g * TT + t) * DM + 16 * lane;
#pragma unroll
            for (int hv = 0; hv < 2; ++hv) { const u32x4 v = *(const u32x4*)(src + 8 * hv);
                acc[8 * hv + 0] += w[g] * __uint_as_float(v.x << 16); acc[8 * hv + 1] += w[g] * __uint_as_float(v.x & 0xffff0000u); acc[8 * hv + 2] += w[g] * __uint_as_float(v.y << 16); acc[8 * hv + 3] += w[g] * __uint_as_float(v.y & 0xffff0000u);
                acc[8 * hv + 4] += w[g] * __uint_as_float(v.z << 16); acc[8 * hv + 5] += w[g] * __uint_as_float(v.z & 0xffff0000u); acc[8 * hv + 6] += w[g] * __uint_as_float(v.w << 16); acc[8 * hv + 7] += w[g] * __uint_as_float(v.w & 0xffff0000u); } }
#pragma unroll
        for (int hv = 0; hv < 2; ++hv) { u32x4 o; o.x = cvtpk(acc[8 * hv], acc[8 * hv + 1]); o.y = cvtpk(acc[8 * hv + 2], acc[8 * hv + 3]); o.z = cvtpk(acc[8 * hv + 4], acc[8 * hv + 5]); o.w = cvtpk(acc[8 * hv + 6], acc[8 * hv + 7]);
            *(u32x4*)(F.MIXIN + (size_t)t * 2048 + 1024 + 16 * lane + 8 * hv) = o; }
    }
}
__device__ __forceinline__ void p3_conv(const Ctx& F) {
    const int tid = F.wave * 64 + lane_id_fresh();
    if (tid >= 384) return;
    const int cg = tid % 192, half = tid / 192, c0 = cg * 8;
    float w[5][8], bias[8];
#pragma unroll
    for (int i = 0; i < 5; ++i) { const f32x4 a = *(const f32x4*)(F.conv_w + i * XBCW + c0), b = *(const f32x4*)(F.conv_w + i * XBCW + c0 + 4);
        w[i][0] = a.x; w[i][1] = a.y; w[i][2] = a.z; w[i][3] = a.w; w[i][4] = b.x; w[i][5] = b.y; w[i][6] = b.z; w[i][7] = b.w; }
    { const f32x4 a = *(const f32x4*)(F.conv_b + c0), b = *(const f32x4*)(F.conv_b + c0 + 4); bias[0] = a.x; bias[1] = a.y; bias[2] = a.z; bias[3] = a.w; bias[4] = b.x; bias[5] = b.y; bias[6] = b.z; bias[7] = b.w; }
    for (int u = F.bid; u < TT / 64; u += F.G) {
        const int tbase = u * 64 + half * 32, pos0 = tbase % SEQ;
        const bf16_t* src = F.PROJ + (size_t)tbase * NPROJ + C_XBC + c0;
        u32x4 rows[36];
#pragma unroll
        for (int i = 0; i < 36; ++i) { const int p = pos0 + i - 2; rows[i] = (p >= 0 && p < SEQ) ? *(const u32x4*)(src + (ptrdiff_t)(i - 2) * NPROJ) : (u32x4){0u, 0u, 0u, 0u}; }
#pragma unroll
        for (int t = 0; t < 32; ++t) {
            float acc[8];
#pragma unroll
            for (int k = 0; k < 8; ++k) acc[k] = bias[k];
#pragma unroll
            for (int i = 0; i < 5; ++i) { const u32x4 v = rows[t + i];
                acc[0] += __uint_as_float(v.x << 16) * w[i][0]; acc[1] += __uint_as_float(v.x & 0xffff0000u) * w[i][1]; acc[2] += __uint_as_float(v.y << 16) * w[i][2]; acc[3] += __uint_as_float(v.y & 0xffff0000u) * w[i][3];
                acc[4] += __uint_as_float(v.z << 16) * w[i][4]; acc[5] += __uint_as_float(v.z & 0xffff0000u) * w[i][5]; acc[6] += __uint_as_float(v.w << 16) * w[i][6]; acc[7] += __uint_as_float(v.w & 0xffff0000u) * w[i][7]; }
            u32x4 o; o.x = pk2(siluf(acc[0]), siluf(acc[1])); o.y = pk2(siluf(acc[2]), siluf(acc[3])); o.z = pk2(siluf(acc[4]), siluf(acc[5])); o.w = pk2(siluf(acc[6]), siluf(acc[7]));
            *(u32x4*)(F.XC + (size_t)(tbase + t) * XBCW + c0) = o;
        }
    }
}
__device__ __forceinline__ int ximg_off(int s, int p) { return s * 128 + ((((p >> 4) ^ ((s >> 1) & 3))) << 5) + (p & 15) * 2; }

__device__ __forceinline__ void p4_states(const Ctx& F) {
    const int lane = lane_id_fresh(), wave = F.wave, tid = wave * 64 + lane, fr = lane & 15, fq = lane >> 4;
    LAS unsigned char* BIMG = F.lds;
    LAS unsigned char* XIMG = F.lds + 32768;
    LAS float* WTAB = (LAS float*)(F.lds + 98304);
    for (int u = F.bid; u < 256; u += F.G) {
        const int g = u & 1, c = (u >> 1) & 63, b = u >> 7; const size_t t0 = (size_t)b * SEQ + c * 128;
        const int b_rsub = tid >> 4, b_c16 = tid & 15, x_rsub = tid >> 5, x_c32 = tid & 31;
        const bf16_t* bgp = F.XC + (t0 + b_rsub) * XBCW + 1024 + g * 128 + b_c16 * 8;
        const bf16_t* xgp = F.XC + (t0 + x_rsub) * XBCW + (g * 8) * 64 + x_c32 * 8;
        LAS unsigned char* blp = BIMG + b_rsub * 256 + (((b_c16 >> 1) ^ (b_rsub & 7)) << 5) + (b_c16 & 1) * 16;
        LAS unsigned char* xlp = XIMG + (x_c32 >> 3) * 16384 + x_rsub * 128 + ((((x_c32 & 7) >> 1) ^ ((x_rsub >> 1) & 3)) << 5) + (x_c32 & 1) * 16;
        u32x4 bi[4], xi[8];
#pragma unroll
        for (int i = 0; i < 4; ++i) bi[i] = *(const u32x4*)(bgp + (size_t)i * 32 * XBCW);
#pragma unroll
        for (int i = 0; i < 8; ++i) xi[i] = *(const u32x4*)(xgp + (size_t)i * 16 * XBCW);
        {
            const int hd = g * 8 + wave;
            float a2v[2], d0v[2], d1v[2];
#pragma unroll
            for (int dir = 0; dir < 2; ++dir) { a2v[dir] = F.a_log[dir * 16 + hd]; d0v[dir] = F.DT[(t0 + lane) * 32 + dir * 16 + hd]; d1v[dir] = F.DT[(t0 + 64 + lane) * 32 + dir * 16 + hd]; }
#pragma unroll
            for (int dir = 0; dir < 2; ++dir) {
                const float a2 = -__expf(a2v[dir]) * LOG2E;
                const float d0 = d0v[dir], d1 = d1v[dir];
                float p0 = a2 * d0, p1 = a2 * d1;
#pragma unroll
                for (int o = 1; o < 64; o <<= 1) { const float q0 = __shfl_up(p0, o), q1 = __shfl_up(p1, o); if (lane >= o) { p0 += q0; p1 += q1; } }
                const float tot0 = __shfl(p0, 63), tot1 = __shfl(p1, 63), tot = tot0 + tot1;
                float c0, c1, w0, w1;
                if (dir == 0) { c0 = p0; c1 = tot0 + p1; w0 = exp2f(tot - c0) * d0; w1 = exp2f(tot - c1) * d1; }
                else { c0 = tot - (p0 - a2 * d0); c1 = tot - (tot0 + p1 - a2 * d1); w0 = exp2f(tot - c0) * d0; w1 = exp2f(tot - c1) * d1; }
                F.CUM[(t0 + lane) * 32 + dir * 16 + hd] = c0; F.CUM[(t0 + 64 + lane) * 32 + dir * 16 + hd] = c1;
                WTAB[(dir * 8 + wave) * 128 + lane] = w0; WTAB[(dir * 8 + wave) * 128 + 64 + lane] = w1;
                if (lane == 0) F.CHDEC[((b * 2 + dir) * 64 + c) * 16 + hd] = exp2f(tot);
            }
        }
#pragma unroll
        for (int i = 0; i < 4; ++i) *(LAS u32x4*)(blp + i * 32 * 256) = bi[i];
#pragma unroll
        for (int i = 0; i < 8; ++i) *(LAS u32x4*)(xlp + i * 16 * 128) = xi[i];
        __syncthreads();
#pragma unroll
        for (int i = 0; i < 8; ++i) xi[i] = *(const u32x4*)(xgp + 4 * 64 + (size_t)i * 16 * XBCW);
        auto quad = [&](const int hq) __attribute__((always_inline)) {
            const int q = wave >> 1, dir = wave & 1, hd = g * 8 + hq * 4 + q;
            const LAS float* wt = WTAB + (dir * 8 + hq * 4 + q) * 128 + 4 * fq;
            const int rq = (lane & 15) >> 2, cq = lane & 3, rl = 4 * fq + rq;
            const LAS unsigned char* xrow = XIMG + q * 16384 + rl * 128 + cq * 8;
            const LAS unsigned char* brow = BIMG + rl * 256 + cq * 8;
            const int xsw = (rl >> 1) & 3, bsw = rl & 7;
            bf16_t* So = F.STATES + ((size_t)((b * 2 + dir) * 64 + c) * 16 + hd) * 8192;
#pragma unroll 1
            for (int nh = 0; nh < 2; ++nh) {
                f32x4 acc[4][4];
#pragma unroll
                for (int nt = 0; nt < 4; ++nt)
#pragma unroll
                    for (int pt = 0; pt < 4; ++pt) acc[nt][pt] = (f32x4){0.f, 0.f, 0.f, 0.f};
#pragma unroll
                for (int ks = 0; ks < 4; ++ks) {
                    const f32x4 w1 = *(const LAS f32x4*)(wt + 32 * ks), w2 = *(const LAS f32x4*)(wt + 32 * ks + 16);
                    bf16x8 xb[4];
#pragma unroll
                    for (int pt = 0; pt < 4; ++pt) {
                        const LAS unsigned char* xp = xrow + ((pt ^ xsw) << 5);
                        const s16x4 a = tr_read(xp + (32 * ks) * 128), bq = tr_read(xp + (32 * ks + 16) * 128);
                        u32x4 o;
                        o.x = cvtpk(bf2f((bf16_t)a[0]) * w1[0], bf2f((bf16_t)a[1]) * w1[1]); o.y = cvtpk(bf2f((bf16_t)a[2]) * w1[2], bf2f((bf16_t)a[3]) * w1[3]);
                        o.z = cvtpk(bf2f((bf16_t)bq[0]) * w2[0], bf2f((bf16_t)bq[1]) * w2[1]); o.w = cvtpk(bf2f((bf16_t)bq[2]) * w2[2], bf2f((bf16_t)bq[3]) * w2[3]);
                        xb[pt] = __builtin_bit_cast(bf16x8, o);
                    }
#pragma unroll
                    for (int nt = 0; nt < 4; ++nt) {
                        const LAS unsigned char* bp = brow + (((nh * 4 + nt) ^ bsw) << 5);
                        const bf16x8 bt = cat8(tr_read(bp + (32 * ks) * 256), tr_read(bp + (32 * ks + 16) * 256));
#pragma unroll
                        for (int pt = 0; pt < 4; ++pt) acc[nt][pt] = __builtin_amdgcn_mfma_f32_16x16x32_bf16(bt, xb[pt], acc[nt][pt], 0, 0, 0);
                    }
                }
#pragma unroll
                for (int nt = 0; nt < 4; ++nt)
#pragma unroll
                    for (int pt = 0; pt < 4; ++pt) { u32x2 o; o.x = cvtpk(acc[nt][pt][0], acc[nt][pt][1]); o.y = cvtpk(acc[nt][pt][2], acc[nt][pt][3]);
                        *(u32x2*)(So + (16 * pt + fr) * 128 + 16 * (nh * 4 + nt) + 4 * fq) = o; }
            }
        };
        quad(0);
        __syncthreads();
#pragma unroll
        for (int i = 0; i < 8; ++i) *(LAS u32x4*)(xlp + i * 16 * 128) = xi[i];
        __syncthreads();
        quad(1);
        __syncthreads();
    }
}

__device__ __forceinline__ void p5_scan(const Ctx& F) {
    const int NTH = F.G * NTHREADS, f_tid = F.wave * 64 + lane_id_fresh();
    for (int gid = F.bid * NTHREADS + f_tid; gid < 2 * 2 * 16 * 64 * 32; gid += NTH) {
        const int n4 = gid & 31, p = (gid >> 5) & 63, hd = (gid >> 11) & 15, dir = (gid >> 15) & 1, b = gid >> 16;
        const size_t eoff = ((size_t)((b * 2 + dir) * 64) * 16 + hd) * 8192 + p * 128 + n4 * 4;
        const bf16_t* base = F.STATES + eoff; bf16_t* obase = F.HPREV + eoff;
        const float* dec = F.CHDEC + ((b * 2 + dir) * 64) * 16 + hd;
        float h0 = 0.f, h1 = 0.f, h2 = 0.f, h3 = 0.f;
#pragma unroll 8
        for (int i = 0; i < 64; ++i) {
            const int c = dir ? 63 - i : i;
            const u32x2 s = *(const u32x2*)(base + (size_t)c * 16 * 8192); const float d = dec[c * 16];
            u32x2 o; o.x = pk2(h0, h1); o.y = pk2(h2, h3); *(u32x2*)(obase + (size_t)c * 16 * 8192) = o;
            h0 = h0 * d + __uint_as_float(s.x << 16); h1 = h1 * d + __uint_as_float(s.x & 0xffff0000u); h2 = h2 * d + __uint_as_float(s.y << 16); h3 = h3 * d + __uint_as_float(s.y & 0xffff0000u);
        }
    }
}

__device__ __forceinline__ void p6_ssd_out(const Ctx& F) {
    const int lane = lane_id_fresh(), wave = F.wave, fr = lane & 15, fq = lane >> 4;
    LAS unsigned char* BIMG = F.lds;
    LAS unsigned char* XIMG = F.lds + 32768;
    LAS unsigned char* HST = F.lds + 65536;
    LAS float* TABS = (LAS float*)(F.lds + LDSCTL_OFF + 2048);
    LAS float* GSS = (LAS float*)(F.lds + LDSCTL_OFF + 10240);
#pragma unroll 1
    for (int u = F.bid; u < 256; u += F.G) {
        const int tid = wave * 64 + lane_id_fresh();
        const int g = u & 1, c = (u >> 1) & 63, b = u >> 7; const size_t t0 = (size_t)b * SEQ + c * 128;
        const int lrow = 16 * wave + fr;
        __syncthreads();
        if (tid < 256) *(LAS f32x4*)(GSS + 4 * tid) = *(const f32x4*)(F.g_ssd + 4 * tid); else if (tid < 272) GSS[1024 + tid - 256] = F.d_skip[tid - 256];
        { const int i_rsub = tid >> 5, i_c32 = tid & 31, i_row = 2 * i_rsub + (i_c32 >> 4), i_c16 = i_c32 & 15;
            const bf16_t* gp = F.XC + (t0 + i_row) * XBCW + 1024 + g * 128 + i_c16 * 8;
            LAS unsigned char* lp = BIMG + i_row * 256 + ((i_c16 ^ (i_row & 15)) << 4);
            u32x4 bi[4];
#pragma unroll
            for (int i = 0; i < 4; ++i) bi[i] = *(const u32x4*)(gp + (size_t)i * 32 * XBCW);
            asm volatile("" : "+v"(bi[0]), "+v"(bi[1]), "+v"(bi[2]), "+v"(bi[3]));
#pragma unroll
            for (int i = 0; i < 4; ++i) *(LAS u32x4*)(lp + i * 32 * 256) = bi[i]; }
        u32x4 xr[2]; float tr0;
        const int x_rsub = tid >> 3, x_c8 = tid & 7;
        const bf16_t* xg = F.XC + (t0 + x_rsub) * XBCW + (g * 8) * 64 + x_c8 * 8;
        LAS unsigned char* xl = XIMG + x_rsub * 128 + (((x_c8 >> 1) ^ ((x_rsub >> 1) & 3)) << 5) + (x_c8 & 1) * 16;
        const int t_arr = tid >> 7, t_l = tid & 127;
        const float* tg = ((t_arr >> 1) ? F.DT : F.CUM) + (t0 + t_l) * 32 + (t_arr & 1) * 16 + g * 8;
        LAS float* tl = TABS + t_arr * 128 + t_l;
#define LOAD_X(step) do { _Pragma("unroll") for (int i = 0; i < 2; ++i) xr[i] = *(const u32x4*)(xg + (step) * 64 + (size_t)i * 64 * XBCW); tr0 = tg[(step)]; } while (0)
#define STORE_X(buf) do { _Pragma("unroll") for (int i = 0; i < 2; ++i) *(LAS u32x4*)(xl + (buf) * 16384 + i * 64 * 128) = xr[i]; tl[(buf) * 512] = tr0; } while (0)
        int hoff[4];
#pragma unroll
        for (int k = 0; k < 4; ++k) hoff[k] = (lane >> 4) * 128 + (((lane & 15) ^ (4 * k + (lane >> 4))) << 3);
#define H_DMA(step, buf) do { _Pragma("unroll") for (int j = 0; j < 4; ++j) { const int P = wave * 4 + j, dir = P >> 4, pp = P & 15; \
            const bf16_t* hb = F.HPREV + ((size_t)((b * 2 + dir) * 64 + c) * 16 + g * 8 + (step)) * 8192 + pp * 512; \
            __builtin_amdgcn_global_load_lds((const unsigned*)(hb + hoff[j]), (LAS unsigned*)(HST + (buf) * 32768 + dir * 16384 + pp * 1024), 16, 0, 0); } } while (0)
        LOAD_X(0);
        H_DMA(0, 0);
        float ssq = 0.f;
        u32x2 zvn[4];
        const int rq = (lane & 15) >> 2, cq = lane & 3, rl = 4 * fq + rq, xsw = (rl >> 1) & 3;
        const int xself = lrow * 128 + 8 * fq, xselfsw = (lrow >> 1) & 3;
        const size_t tok = t0 + lrow;
        const int ldiff = lrow - 4 * fq;
        const bf16_t* zg = F.PROJ + tok * NPROJ + C_Z + (g * 8) * 64 + 4 * fq;
#pragma unroll
        for (int pt = 0; pt < 4; ++pt) zvn[pt] = *(const u32x2*)(zg + 16 * pt);
        bf16x8 cfr[4]; f32x4 G[8];
#pragma unroll
        for (int ks = 0; ks < 4; ++ks) cfr[ks] = *(const bf16x8*)(F.XC + tok * XBCW + 1280 + g * 128 + 32 * ks + 8 * fq);
        __syncthreads();
#pragma unroll
        for (int st = 0; st < 8; ++st) { f32x4 a = (f32x4){0.f, 0.f, 0.f, 0.f}; const int s = 16 * st + fr;
#pragma unroll
            for (int ks = 0; ks < 4; ++ks) { const bf16x8 bfrag = *(const LAS bf16x8*)(BIMG + s * 256 + (((4 * ks + fq) ^ fr) << 4));
                a = __builtin_amdgcn_mfma_f32_16x16x32_bf16(bfrag, cfr[ks], a, 0, 0, 0); }
            G[st] = a; }
        STORE_X(0);
#pragma unroll 1
        for (int step = 0; step < 8; ++step) {
            const int hd = g * 8 + step, buf = step & 1;
            if (step == 0) asm volatile("s_waitcnt vmcnt(0)" ::: "memory"); else asm volatile("s_waitcnt vmcnt(4)" ::: "memory");
            __syncthreads();
            u32x2 zv[4];
#pragma unroll
            for (int pt = 0; pt < 4; ++pt) zv[pt] = zvn[pt];
            if (step < 7) { H_DMA(step + 1, buf ^ 1); LOAD_X(step + 1);
#pragma unroll
                for (int pt = 0; pt < 4; ++pt) zvn[pt] = *(const u32x2*)(zg + (step + 1) * 64 + 16 * pt); }
            const LAS unsigned char* xi = XIMG + buf * 16384;
            const LAS unsigned char* xrow = xi + rl * 128 + cq * 8;
            const LAS float* tb = TABS + buf * 512;
            const float cfl = tb[lrow], cbl = tb[128 + lrow];
            f32x4 acc[4];
#pragma unroll
            for (int pt = 0; pt < 4; ++pt) acc[pt] = (f32x4){0.f, 0.f, 0.f, 0.f};
#pragma unroll
            for (int dir = 0; dir < 2; ++dir) {
                f32x4 aco[4];
#pragma unroll
                for (int pt = 0; pt < 4; ++pt) aco[pt] = (f32x4){0.f, 0.f, 0.f, 0.f};
                const LAS unsigned char* hs = HST + buf * 32768 + dir * 16384 + fr * 256;
#pragma unroll
                for (int ks = 0; ks < 4; ++ks) {
                    u32x4 hf_[4];
                    const unsigned ha = (unsigned)(unsigned long long)(hs + (((4 * ks + fq) ^ fr) << 4));
                    hf_[0] = lds_read_a<0>(ha); hf_[1] = lds_read_a<4096>(ha); hf_[2] = lds_read_a<8192>(ha); hf_[3] = lds_read_a<12288>(ha);
                    lds_wait4(hf_);
#pragma unroll
                    for (int pt = 0; pt < 4; ++pt) aco[pt] = __builtin_amdgcn_mfma_f32_16x16x32_bf16(__builtin_bit_cast(bf16x8, hf_[pt]), cfr[ks], aco[pt], 0, 0, 0);
                }
                const float el = __builtin_amdgcn_exp2f(dir ? cbl : cfl);
#pragma unroll
                for (int pt = 0; pt < 4; ++pt) acc[pt] = acc[pt] + aco[pt] * el;
            }
            bf16x8 mop[4];
#pragma unroll
            for (int ks = 0; ks < 4; ++ks) {
                unsigned pk[4];
#pragma unroll
                for (int hf = 0; hf < 2; ++hf) {
                    const int st = 2 * ks + hf;
                    const LAS float* ts = tb + 4 * fq + 16 * st;
                    const f32x4 cfs = *(const LAS f32x4*)(ts), cbs = *(const LAS f32x4*)(ts + 128), dfs = *(const LAS f32x4*)(ts + 256), dbs = *(const LAS f32x4*)(ts + 384);
                    float mv[4];
#pragma unroll
                    for (int i = 0; i < 4; ++i) { const bool fw = (16 * st + i) <= ldiff;
                        const float ar = fw ? cfl - cfs[i] : cbl - cbs[i], wg = fw ? dfs[i] : dbs[i];
                        float v = __builtin_amdgcn_exp2f(ar) * wg; if ((16 * st + i) == ldiff) v += dbs[i];
                        mv[i] = v * G[st][i]; }
                    pk[2 * hf] = cvtpk(mv[0], mv[1]); pk[2 * hf + 1] = cvtpk(mv[2], mv[3]);
                }
                mop[ks] = __builtin_bit_cast(bf16x8, (u32x4){pk[0], pk[1], pk[2], pk[3]});
            }
#pragma unroll
            for (int pt = 0; pt < 4; ++pt) { const unsigned xp = (unsigned)(unsigned long long)(xrow + ((pt ^ xsw) << 5));
                u32x2 t[8];
                t[0] = tr_read_a<0>(xp); t[1] = tr_read_a<2048>(xp); t[2] = tr_read_a<4096>(xp); t[3] = tr_read_a<6144>(xp);
                t[4] = tr_read_a<8192>(xp); t[5] = tr_read_a<10240>(xp); t[6] = tr_read_a<12288>(xp); t[7] = tr_read_a<14336>(xp);
                tr_wait8(t);
#pragma unroll
                for (int ks = 0; ks < 4; ++ks) { const bf16x8 xa = __builtin_bit_cast(bf16x8, (u32x4){t[2 * ks].x, t[2 * ks].y, t[2 * ks + 1].x, t[2 * ks + 1].y});
                    acc[pt] = __builtin_amdgcn_mfma_f32_16x16x32_bf16(xa, mop[ks], acc[pt], 0, 0, 0); } }
            if (step < 7) { asm volatile("s_waitcnt vmcnt(0)" ::: "memory");
                STORE_X(buf ^ 1); asm volatile("" : "+v"(zvn[0]), "+v"(zvn[1]), "+v"(zvn[2]), "+v"(zvn[3])); }
            const float dsk = GSS[1024 + hd];
#pragma unroll
            for (int pt = 0; pt < 4; ++pt) {
                const int p0 = 16 * pt + 4 * fq;
                const u32x2 xv = *(const LAS u32x2*)(xi + xself + ((pt ^ xselfsw) << 5));
                const f32x4 gs = *(const LAS f32x4*)(GSS + hd * 64 + p0);
                const float xf[4] = {__uint_as_float(xv.x << 16), __uint_as_float(xv.x & 0xffff0000u), __uint_as_float(xv.y << 16), __uint_as_float(xv.y & 0xffff0000u)};
                const float zf[4] = {__uint_as_float(zv[pt].x << 16), __uint_as_float(zv[pt].x & 0xffff0000u), __uint_as_float(zv[pt].y << 16), __uint_as_float(zv[pt].y & 0xffff0000u)};
                float o[4];
#pragma unroll
                for (int i = 0; i < 4; ++i) { const float y = (acc[pt][i] + dsk * xf[i]) * siluf(zf[i]); ssq += y * y; o[i] = y * gs[i]; }
                u32x2 w; w.x = cvtpk(o[0], o[1]); w.y = cvtpk(o[2], o[3]);
                *(u32x2*)(F.MIXIN + tok * 2048 + hd * 64 + p0) = w;
            }
        }
#undef LOAD_X
#undef STORE_X
#undef H_DMA
        ssq += __shfl_xor(ssq, 16); ssq += __shfl_xor(ssq, 32);
        if (fq == 0) F.RR[(size_t)g * TT + tok] = ssq;
    }
}
__device__ __forceinline__ void p7_postmix(const Ctx& F) {
    const int lane = lane_id_fresh(), wave = F.wave, tid = wave * 64 + lane, fr = lane & 15, fq = lane >> 4;
    LAS unsigned char* HL = F.lds;
    LAS float* PART = (LAS float*)(F.lds + 65536);
    LAS int* SEL = (LAS int*)(F.lds + 81920);
    LAS float* SELW = (LAS float*)(F.lds + 82944);
    LAS int* HIST = (LAS int*)(F.lds + 83968);
    LAS float* CST = (LAS float*)(F.lds + 86016);
    unsigned* ecount = F.ctl + CW_ECOUNT;
    bf16x8 wh[2][4], wl[2][4];
#pragma unroll
    for (int et = 0; et < 2; ++et)
#pragma unroll
        for (int ks = 0; ks < 4; ++ks) { const bf16_t* p = F.WRT + (16 * et + fr) * DM + 128 * wave + 32 * ks + 8 * fq; wh[et][ks] = *(const bf16x8*)p; wl[et][ks] = *(const bf16x8*)(p + NEXP * DM); }
    for (int blk = F.bid; blk < TT / 64; blk += F.G) {
        if (tid < 32) HIST[tid] = 0;
        { const float* mb = F.mod + ((blk * 64) / SEQ) * 6144;
            for (int i = tid; i < 1280; i += NTHREADS) { const int a = i >> 8, c4 = (i & 255) * 4;
                const float* sp = a == 0 ? mb + 2048 : a == 1 ? F.g_post_mix : a == 2 ? F.g_pre_ffn : a == 3 ? mb + 4096 : mb + 3072;
                *(LAS f32x4*)(CST + a * 1024 + c4) = *(const f32x4*)(sp + c4); } }
        u32x2 qn[4]; f32x4 xn[4];
#define PM_LOAD(idx) do { const size_t t_ = (size_t)(blk * 64 + ((idx) >> 1) * 16 + 2 * wave + ((idx) & 1)) * DM + 4 * lane; _Pragma("unroll") for (int j = 0; j < 4; ++j) { \
            qn[j] = *(const u32x2*)(F.MIX + t_ + 256 * j); xn[j] = *(const f32x4*)(F.x + t_ + 256 * j); } } while (0)
        PM_LOAD(0);
        __syncthreads();
#pragma unroll
        for (int grp = 0; grp < 4; ++grp) {
#pragma unroll
            for (int rr = 0; rr < 2; ++rr) {
                const int row = 2 * wave + rr, t = blk * 64 + grp * 16 + row;
                float mv[16], rv[16]; float ss = 0.f;
                f32x4 xc[4];
#pragma unroll
                for (int j = 0; j < 4; ++j) { const u32x2 q = qn[j]; xc[j] = xn[j];
                    const f32x4 v = (f32x4){__uint_as_float(q.x << 16), __uint_as_float(q.x & 0xffff0000u), __uint_as_float(q.y << 16), __uint_as_float(q.y & 0xffff0000u)};
                    mv[4 * j] = v.x; mv[4 * j + 1] = v.y; mv[4 * j + 2] = v.z; mv[4 * j + 3] = v.w; ss += v.x * v.x + v.y * v.y + v.z * v.z + v.w * v.w; }
                if (grp * 2 + rr < 7) PM_LOAD(grp * 2 + rr + 1);
                const float r = rsqrtf(wave_sum(ss) * (1.f / DM) + RMS_EPS);
                float ss2 = 0.f;
#pragma unroll
                for (int j = 0; j < 4; ++j) { const int c0 = 4 * lane + 256 * j; const f32x4 xv = xc[j], gm = *(const LAS f32x4*)(CST + c0), gp = *(const LAS f32x4*)(CST + 1024 + c0);
#pragma unroll
                    for (int i = 0; i < 4; ++i) { const float v = xv[i] + gm[i] * (mv[4 * j + i] * r * gp[i]); rv[4 * j + i] = v; ss2 += v * v; } }
                const float r2 = rsqrtf(wave_sum(ss2) * (1.f / DM) + RMS_EPS);
#pragma unroll
                for (int j = 0; j < 4; ++j) {
                    const int c0 = 4 * lane + 256 * j; const f32x4 gp = *(const LAS f32x4*)(CST + 2048 + c0), sc = *(const LAS f32x4*)(CST + 3072 + c0), sh = *(const LAS f32x4*)(CST + 4096 + c0);
                    float hv[4];
#pragma unroll
                    for (int i = 0; i < 4; ++i) hv[i] = rv[4 * j + i] * r2 * gp[i] * (1.f + sc[i]) + sh[i];
                    { u32x2 rq; rq.x = cvtpk(rv[4 * j], rv[4 * j + 1]); rq.y = cvtpk(rv[4 * j + 2], rv[4 * j + 3]); *(u32x2*)(F.RES + (size_t)t * DM + c0) = rq; }
                    u32x2 hi; hi.x = cvtpk(hv[0], hv[1]); hi.y = cvtpk(hv[2], hv[3]);
                    *(u32x2*)(F.H + (size_t)t * DM + c0) = hi;
                    u32x2 lo; lo.x = cvtpk(hv[0] - __uint_as_float(hi.x << 16), hv[1] - __uint_as_float(hi.x & 0xffff0000u)); lo.y = cvtpk(hv[2] - __uint_as_float(hi.y << 16), hv[3] - __uint_as_float(hi.y & 0xffff0000u));
                    const int chunk = (lane >> 1) + 32 * j, off = row * 4096 + ((chunk ^ row) << 4) + (lane & 1) * 8;
                    *(LAS u32x2*)(HL + off) = hi; *(LAS u32x2*)(HL + 2048 + off) = lo;
                }
            }
            __syncthreads();
            { f32x4 acc[2] = {(f32x4){0.f, 0.f, 0.f, 0.f}, (f32x4){0.f, 0.f, 0.f, 0.f}};
#pragma unroll
                for (int ks = 0; ks < 4; ++ks) { const int off = fr * 4096 + (((16 * wave + 4 * ks + fq) ^ fr) << 4);
                    const bf16x8 ah = *(const LAS bf16x8*)(HL + off), al = *(const LAS bf16x8*)(HL + 2048 + off);
#pragma unroll
                    for (int et = 0; et < 2; ++et) { acc[et] = __builtin_amdgcn_mfma_f32_16x16x32_bf16(al, wh[et][ks], acc[et], 0, 0, 0); acc[et] = __builtin_amdgcn_mfma_f32_16x16x32_bf16(ah, wl[et][ks], acc[et], 0, 0, 0);
                        acc[et] = __builtin_amdgcn_mfma_f32_16x16x32_bf16(ah, wh[et][ks], acc[et], 0, 0, 0); } }
#pragma unroll
                for (int et = 0; et < 2; ++et)
#pragma unroll
                    for (int i = 0; i < 4; ++i) PART[(wave * 16 + 4 * fq + i) * 32 + 16 * et + fr] = acc[et][i]; }
            __syncthreads();
            { const int e = lane & 31, row = 2 * wave + (lane >> 5);
                float v = F.b_router[e];
#pragma unroll
                for (int w = 0; w < 8; ++w) v += PART[(w * 16 + row) * 32 + e];
                int ti[4]; float tv[4];
#pragma unroll
                for (int k = 0; k < 4; ++k) {
                    float bv = v; int bi = e;
#pragma unroll
                    for (int o = 16; o >= 1; o >>= 1) { const float ov = __shfl_xor(bv, o); const int oi = __shfl_xor(bi, o); if (ov > bv || (ov == bv && oi < bi)) { bv = ov; bi = oi; } }
                    ti[k] = bi; tv[k] = bv; if (e == bi) v = -INFINITY;
                }
                const float e1 = __expf(tv[1] - tv[0]), e2 = __expf(tv[2] - tv[0]), e3 = __expf(tv[3] - tv[0]), inv = 1.f / (1.f + e1 + e2 + e3);
                if (e < 4) { int ex = ti[0]; float w = inv;
                    if (e == 1) { ex = ti[1]; w = e1 * inv; } else if (e == 2) { ex = ti[2]; w = e2 * inv; } else if (e == 3) { ex = ti[3]; w = e3 * inv; }
                    SEL[(grp * 16 + row) * 4 + e] = ex; SELW[(grp * 16 + row) * 4 + e] = w; } }
            __syncthreads();
        }
#undef PM_LOAD
        int myex = 0, myloc = 0;
        if (tid < 256) { myex = SEL[tid]; myloc = __hip_atomic_fetch_add(&HIST[myex], 1, __ATOMIC_RELAXED, __HIP_MEMORY_SCOPE_WORKGROUP); }
        __syncthreads();
        if (tid < 32) { const int c = HIST[tid]; HIST[32 + tid] = c ? (int)atomicAdd(&ecount[tid], (unsigned)c) : 0; }
        __syncthreads();
        if (tid < 256) { const int slot = (blk * 64 + (tid >> 2)) * 4 + (tid & 3); const int pos = myex * TT + HIST[32 + myex] + myloc; F.SORT[pos] = slot; F.SORTW[pos] = SELW[tid]; }
        __syncthreads();
    }
}
__device__ __forceinline__ void p10_final(const Ctx& F) {
    const int gw = F.bid * NWAVES + F.wave, NGW = F.G * NWAVES, lane = lane_id_fresh();
    for (int t0 = gw; t0 < TT; t0 += 2 * NGW) {
        const int tt[2] = {t0, t0 + NGW < TT ? t0 + NGW : t0};
        u32x2 y[2][4][4], rq[2][4];
#pragma unroll
        for (int q = 0; q < 2; ++q)
#pragma unroll
            for (int j = 0; j < 4; ++j) { const int c0 = 4 * lane + 256 * j;
#pragma unroll
                for (int k = 0; k < 4; ++k) y[q][j][k] = *(const u32x2*)(F.YSLOT + (size_t)(tt[q] * 4 + k) * DM + c0);
                rq[q][j] = *(const u32x2*)(F.RES + (size_t)tt[q] * DM + c0); }
        f32x4 gg[2][4];
#pragma unroll
        for (int q = 0; q < 2; ++q) { const float* gate = F.mod + (tt[q] / SEQ) * 6144 + 5120;
#pragma unroll
            for (int j = 0; j < 4; ++j) { const int c0 = 4 * lane + 256 * j; if (q == 0 || tt[1] / SEQ != tt[0] / SEQ) gg[q][j] = *(const f32x4*)(gate + c0) * *(const f32x4*)(F.g_post_ffn + c0); else gg[q][j] = gg[0][j]; } }
#pragma unroll
        for (int q = 0; q < 2; ++q) {
            const int t = tt[q];
            float f[16]; float ss = 0.f;
#pragma unroll
            for (int j = 0; j < 4; ++j) { float s[4] = {0.f, 0.f, 0.f, 0.f};
#pragma unroll
                for (int k = 0; k < 4; ++k) { const u32x2 v = y[q][j][k];
                    s[0] += __uint_as_float(v.x << 16); s[1] += __uint_as_float(v.x & 0xffff0000u); s[2] += __uint_as_float(v.y << 16); s[3] += __uint_as_float(v.y & 0xffff0000u); }
#pragma unroll
                for (int i = 0; i < 4; ++i) { f[4 * j + i] = s[i]; ss += s[i] * s[i]; } }
            const float r = rsqrtf(wave_sum(ss) * (1.f / DM) + RMS_EPS);
#pragma unroll
            for (int j = 0; j < 4; ++j) { const int c0 = 4 * lane + 256 * j; const f32x4 g4 = gg[q][j]; const u32x2 rr = rq[q][j];
                f32x4 o = (f32x4){__uint_as_float(rr.x << 16), __uint_as_float(rr.x & 0xffff0000u), __uint_as_float(rr.y << 16), __uint_as_float(rr.y & 0xffff0000u)};
#pragma unroll
                for (int i = 0; i < 4; ++i) o[i] += g4[i] * (f[4 * j + i] * r);
                *(f32x4*)(F.out + (size_t)t * DM + c0) = o; }
        }
    }
}

struct Args { const float* in[22]; float* out; unsigned char* ws; int ph_lo, ph_hi; };
__global__ void __launch_bounds__(NTHREADS, 2) mk_fwd(Args args) {
    extern __shared__ __attribute__((aligned(16))) unsigned char lds_raw[];
    Ctx F;
    F.lds = (LAS unsigned char*)lds_raw; F.wave = __builtin_amdgcn_readfirstlane((int)threadIdx.x >> 6); F.G = gridDim.x; F.bid = blockIdx.x;
    unsigned char* ws = args.ws;
    F.x = args.in[0]; F.c = args.in[1]; F.w_ada = args.in[2]; F.b_ada = args.in[3]; F.g_pre_mix = args.in[4]; F.g_post_mix = args.in[5]; F.w_in = args.in[6];
    F.conv_w = args.in[7]; F.conv_b = args.in[8]; F.dt_bias = args.in[9]; F.a_log = args.in[10]; F.d_skip = args.in[11]; F.g_ssd = args.in[12]; F.w_out = args.in[13];
    F.g_pre_ffn = args.in[14]; F.g_post_ffn = args.in[15]; F.w_router = args.in[16]; F.b_router = args.in[17]; F.w_gu = args.in[18]; F.b_gu = args.in[19]; F.w_dn = args.in[20]; F.b_dn = args.in[21];
    F.out = args.out; F.ctl = (unsigned*)(ws + WS_CTL); F.mod = (float*)(ws + WS_MOD);
    F.WIN = (bf16_t*)(ws + WS_WIN); F.WOUT = (bf16_t*)(ws + WS_WOUT); F.WGU = (bf16_t*)(ws + WS_WGU); F.WDN = (bf16_t*)(ws + WS_WDN);
    F.H = (bf16_t*)(ws + WS_H); F.PROJ = (bf16_t*)(ws + WS_PROJ); F.XC = (bf16_t*)(ws + WS_XC); F.DT = (float*)(ws + WS_DT);
    F.STATES = (bf16_t*)(ws + WS_STATES); F.CUM = (float*)(ws + WS_CUM); F.CHDEC = (float*)(ws + WS_CHDEC); F.OPART = (bf16_t*)(ws + WS_OPART); F.HPREV = (bf16_t*)(ws + WS_HPREV); F.WRT = (bf16_t*)(ws + WS_WRT); F.RES = (bf16_t*)(ws + WS_RES); F.LSE = (float*)(ws + WS_LSE); F.MIXIN = (bf16_t*)(ws + WS_MIXIN); F.MIX = (bf16_t*)(ws + WS_MIX);
    F.TOPW = (float*)(ws + WS_TOPW); F.SORT = (int*)(ws + WS_SORT); F.SORTW = (float*)(ws + WS_SORTW); F.RR = (float*)(ws + WS_RR); F.ACT = (bf16_t*)(ws + WS_ACT); F.YSLOT = (bf16_t*)(ws + WS_YSLOT);
    volatile LAS unsigned* LCTL = (volatile LAS unsigned*)(F.lds + LDSCTL_OFF);
    for (int u = (int)threadIdx.x; u < (LDS_BYTES - LDSCTL_OFF) / 4; u += NTHREADS) LCTL[u] = 0u;
    __syncthreads();
    XcdBarrier bar; bar.bar = F.ctl + CW_BAR; bar.x = 0; bar.st = nullptr;
    if (MK_N_LAUNCHES == 1) bar = xcd_barrier_post(F.ctl + CW_BAR, LCTL);
    const int lo = args.ph_lo, hi = args.ph_hi;
#define IN(k) (lo <= (k) && (k) < hi)
Fill fs; fs.pend = -1; fs.mpend = -1; fs.mopen = 0; fs.wdone = 0; fs.mdone = 0;
#define SEAM(k) do { if (IN(k) && IN((k) + 1)) xcd_barrier_fill(bar, F, fs); } while (0)

    if (IN(0)) { for (int rep_ = 0; rep_ < (DUP_PHASE == 0 ? 2 : 1); ++rep_) p0_prologue(F); }
    if (IN(1)) { for (int rep_ = 0; rep_ < (DUP_PHASE == 1 ? 2 : 1); ++rep_) p1_prenorm(F); } SEAM(1);
    if (DUP_PHASE == 20) { for (int rep_ = 0; rep_ < 4; ++rep_) xcd_barrier(bar, F.wave); }
    if (IN(2)) {
        pg8::Gemm g{F.H, F.WIN, DM}; pg8::DenseOrder<TT, NPROJ_PAD, DM> S; S.init(F.G, F.bid);
        pg8::EpiInproj E{F.PROJ, F.DT, F.dt_bias};
        for (int rep_ = 0; rep_ < (DUP_PHASE == 2 ? 2 : 1); ++rep_) pg8::gemm_phase<pg8::EpiInproj, pg8::DenseOrder<TT, NPROJ_PAD, DM>, true>(F.lds, g, S, E, F.wave);
    } SEAM(2);
    if (IN(3)) { for (int rep_ = 0; rep_ < (DUP_PHASE == 3 ? 2 : 1); ++rep_) p3_attention(F); for (int rep_ = 0; rep_ < (DUP_PHASE == 13 ? 2 : 1); ++rep_) p3_conv(F); } SEAM(3);
    fs.mopen = 1;
    if (IN(4)) { for (int rep_ = 0; rep_ < (DUP_PHASE == 4 ? 2 : 1); ++rep_) p4_states(F); } SEAM(4);
    if (IN(5)) { for (int rep_ = 0; rep_ < (DUP_PHASE == 5 ? 2 : 1); ++rep_) p5_scan(F); } SEAM(5);
    if (IN(6)) { for (int rep_ = 0; rep_ < (DUP_PHASE == 6 ? 2 : 1); ++rep_) p6_ssd_out(F); }
    fill_drain(F, fs, 2, 0, LCTL);
    SEAM(6);
    if (IN(7)) {
        pg8::Gemm g{F.MIXIN, F.WOUT, 2048}; pg8::DenseOrder<TT, DM, 2048> S; S.init(F.G, F.bid);
        pg8::EpiBf16 E{F.MIX, DM, F.RR};
        for (int rep_ = 0; rep_ < (DUP_PHASE == 7 ? 2 : 1); ++rep_) pg8::gemm_phase<pg8::EpiBf16, pg8::DenseOrder<TT, DM, 2048>, true>(F.lds, g, S, E, F.wave);
    } SEAM(7);
    if (IN(8)) { p7_postmix(F); }
    __syncthreads();
    fill_drain(F, fs, 1, FQ_GU, LCTL);
    SEAM(8);
    if (IN(9) || IN(10)) {
        LAS int* tcum = (LAS int*)(F.lds + LDSCTL_OFF + 64); LAS int* cnt = (LAS int*)(F.lds + LDSCTL_OFF + 256); LAS int* texp = (LAS int*)(F.lds + LDSCTL_OFF + 512);
        const int vcu = (F.G % 8 == 0) ? (F.bid % 8) * (F.G / 8) + F.bid / 8 : F.bid;
        if (F.wave == 0 && lane_id_fresh() == 0) { int cum = 0; for (int e = 0; e < NEXP; ++e) { const int c = (int)__hip_atomic_load(F.ctl + CW_ECOUNT + e, __ATOMIC_RELAXED, __HIP_MEMORY_SCOPE_AGENT); cnt[e] = c; tcum[e] = cum; cum += (c + 255) >> 8; } tcum[NEXP] = cum; }
        __syncthreads();
        { const int rt = F.wave * 64 + lane_id_fresh(); if (rt < 320) { int e = 0; for (int j = 1; j < NEXP; ++j) if (tcum[j] <= rt) e = j; texp[rt] = e; } }
        __syncthreads();
        if (IN(9)) {
            pg8::Gemm g{F.H, F.WGU, DM}; pg8::MoeOrder S{tcum, cnt, texp, F.SORT, 3, F.G, vcu, DM, (size_t)2048 * DM * 2, true};
            pg8::EpiSwiglu E{F.ACT, F.b_gu};
            for (int rep_ = 0; rep_ < (DUP_PHASE == 9 ? 2 : 1); ++rep_) pg8::gemm_phase<pg8::EpiSwiglu, pg8::MoeOrder, true>(F.lds, g, S, E, F.wave);
        }
        __syncthreads();
        fill_drain(F, fs, 1, FQ_ALL, LCTL);
        SEAM(9);
        if (IN(10)) {
            pg8::Gemm g{F.ACT, F.WDN, FF}; pg8::MoeOrder S{tcum, cnt, texp, F.SORT, 2, F.G, vcu, FF, (size_t)DM * FF * 2, false};
            pg8::EpiDown E{F.YSLOT, F.b_dn, F.SORT, F.SORTW};
            for (int rep_ = 0; rep_ < (DUP_PHASE == 10 ? 2 : 1); ++rep_) pg8::gemm_phase<pg8::EpiDown, pg8::MoeOrder, true>(F.lds, g, S, E, F.wave);
        }
    }
    SEAM(10);
    if (IN(11)) { for (int rep_ = 0; rep_ < (DUP_PHASE == 11 ? 2 : 1); ++rep_) p10_final(F); }
#undef IN
#undef SEAM
}

extern "C" void kernel_launch(void* const* d_in, const int* in_sizes, int n_in, void* d_out, int out_size, void* d_ws, size_t ws_size, hipStream_t stream) {
    static int grid = 0;
    if (grid == 0) {
        if (n_in != 22 || ws_size < WS_END) { fprintf(stderr, "kernel_launch: unexpected n_in %d / ws %zu\n", n_in, ws_size); grid = -1; return; }
        int dev = 0, cus = 0, per_cu = 0;
        if (hipGetDevice(&dev) != hipSuccess || hipDeviceGetAttribute(&cus, hipDeviceAttributeMultiprocessorCount, dev) != hipSuccess) { grid = -1; return; }
        if (hipFuncSetAttribute((const void*)mk_fwd, hipFuncAttributeMaxDynamicSharedMemorySize, LDS_BYTES) != hipSuccess) { fprintf(stderr, "kernel_launch: hipFuncSetAttribute failed\n"); grid = -1; return; }
        if (hipOccupancyMaxActiveBlocksPerMultiprocessor(&per_cu, (const void*)mk_fwd, NTHREADS, LDS_BYTES) != hipSuccess || per_cu < 1) fprintf(stderr, "kernel_launch: occupancy query says %d\n", per_cu);
        (void)hipGetLastError();
        grid = cus;
    }
    if (grid < 0) return;
    (void)hipMemsetAsync((char*)d_ws + WS_CTL, 0, CTL_BYTES, stream);
    Args a{};
    for (int i = 0; i < 22; ++i) a.in[i] = (const float*)d_in[i];
    a.out = (float*)d_out; a.ws = (unsigned char*)d_ws;
    for (int li = 0; li < MK_N_LAUNCHES; ++li) {
        if (MK_N_LAUNCHES == 1) { a.ph_lo = 0; a.ph_hi = N_PHASES; } else { a.ph_lo = li; a.ph_hi = li + 1; }
        hipLaunchKernelGGL(mk_fwd, dim3(grid), dim3(NTHREADS), LDS_BYTES, stream, a);
    }
}
```

```cpp
#include <hip/hip_runtime.h>
#include <cstdio>
#include <cstdint>

#define LAS __attribute__((address_space(3)))
#define GAS __attribute__((address_space(1)))
typedef unsigned short bf16_t;
typedef short bf16x8 __attribute__((ext_vector_type(8)));
typedef float f32x4 __attribute__((ext_vector_type(4)));
typedef unsigned u32x4 __attribute__((ext_vector_type(4)));
typedef unsigned u32x2 __attribute__((ext_vector_type(2)));
typedef GAS unsigned gu32;

#ifndef DUP_PHASE
#define DUP_PHASE -1
#endif
#ifndef MK_N_LAUNCHES
#define MK_N_LAUNCHES 1
#endif
constexpr int N_PHASES = 12;

constexpr int BATCH = 2, SEQ = 8192, DM = 1024, TT = BATCH * SEQ;
constexpr int NPROJ = 5632, NPROJ_ALL = 5664, NPROJ_PAD = 5888;
constexpr int C_Q = 0, C_K = 1024, C_V = 2048, C_Z = 3072, C_XBC = 4096;
constexpr int XBCW = 1536;
constexpr int NEXP = 32, FF = 1024;
constexpr float RMS_EPS = 1e-6f;
constexpr int NWAVES = 8, NTHREADS = 512;

constexpr size_t MiB = 1u << 20;
constexpr size_t WS_CTL = 0, CTL_BYTES = 65536;
constexpr size_t WS_MOD = 1 * MiB;
constexpr size_t WS_WIN = 2 * MiB;
constexpr size_t WS_WOUT = 14 * MiB;
constexpr size_t WS_WGU = 18 * MiB;
constexpr size_t WS_WDN = 146 * MiB;
constexpr size_t WS_H = 210 * MiB;
constexpr size_t WS_PROJ = 242 * MiB;
constexpr size_t WS_XC = 418 * MiB;
constexpr size_t WS_DT = 466 * MiB;
constexpr size_t WS_STATES = 468 * MiB;
constexpr size_t WS_CUM = 532 * MiB;
constexpr size_t WS_CHDEC = 534 * MiB;
constexpr size_t WS_MIXIN = 596 * MiB;
constexpr size_t WS_MIX = 660 * MiB;
constexpr size_t WS_TOPW = 724 * MiB;
constexpr size_t WS_SORT = 725 * MiB;
constexpr size_t WS_SORTW = 536 * MiB;
constexpr size_t WS_RR = 538 * MiB;
constexpr size_t WS_ACT = 242 * MiB;
constexpr size_t WS_YSLOT = 386 * MiB;
constexpr size_t WS_WRT = 535 * MiB;
constexpr size_t WS_OPART = 728 * MiB;
constexpr size_t WS_LSE = 824 * MiB;
constexpr size_t WS_HPREV = 828 * MiB;
constexpr size_t WS_RES = 892 * MiB;
constexpr size_t WS_END = 956 * MiB;

constexpr size_t WS_QKV = 828 * MiB;
constexpr size_t WS_FLG = 256 * 1024;
constexpr int QROWS = 8192;
constexpr int QBASE_ROWS = (int)((WS_HPREV - WS_YSLOT) / (DM * 2));
constexpr int CW_ECOUNT = 64;
constexpr int CW_MODCNT = 1024;
constexpr int CW_BAR = 4096;
constexpr int CW_FQ = 9216, CW_MQ = 9280;

constexpr int RING_BYTES = 131072;
constexpr int LDSCTL_OFF = RING_BYTES;
constexpr int LDS_BYTES = 147456;

__device__ __forceinline__ float bf2f(bf16_t v) { return __uint_as_float(((unsigned)v) << 16); }
__device__ __forceinline__ bf16_t f2bf(float f) { unsigned u = __float_as_uint(f); return (bf16_t)((u + 0x7fffu + ((u >> 16) & 1u)) >> 16); }
typedef float f32x2_t __attribute__((ext_vector_type(2))); typedef __bf16 bf16x2_t __attribute__((ext_vector_type(2)));
__device__ __forceinline__ unsigned pk2(float lo, float hi) { f32x2_t v = {lo, hi}; bf16x2_t b = __builtin_convertvector(v, bf16x2_t); return __builtin_bit_cast(unsigned, b); }
__device__ __forceinline__ float wave_sum(float v) {
#pragma unroll
    for (int o = 1; o < 64; o <<= 1) v += __shfl_xor(v, o);
    return v;
}
__device__ __forceinline__ float siluf(float x) { return x * __builtin_amdgcn_rcpf(1.f + __expf(-x)); }
#define LDS_WAIT() asm volatile("s_waitcnt lgkmcnt(0)" ::: "memory")
__device__ __forceinline__ int lane_id_fresh() { int l; asm volatile("v_mbcnt_lo_u32_b32 %0, -1, 0\n\tv_mbcnt_hi_u32_b32 %0, -1, %0" : "=v"(l)); return l; }

namespace pg8 {
constexpr int BM = 256, BK = 64, HALF = 128, HTB = HALF * BK * 2, STAGE_BYTES = 8 * HTB;
__host__ __device__ __forceinline__ int lds_byte(int r, int c) { const int st = (r >> 4) * 2 + (c >> 5), rr = r & 15, cc = c & 31, ob = rr * 64 + cc * 2; return st * 1024 + (ob ^ (((ob >> 9) & 1) << 5)); }
__host__ __device__ __forceinline__ void stage_rc(int b, int& R, int& C) { const int st = b / 1024, sb = b % 1024, swz = sb ^ (((sb >> 9) & 1) << 5); R = (st >> 1) * 16 + swz / 64; C = (st & 1) * 32 + (swz % 64) / 2; }
__host__ __device__ __forceinline__ int perm32(int rho) { const int n = rho >> 4, i = rho & 15; return 8 * (i >> 2) + 4 * n + (i & 3); }

struct Unit { int pm, pn, arow0, e, nvalid, lrow0; size_t boff; };
struct Gemm { const bf16_t* A; const bf16_t* Bt; int K; };

template <int M_, int N_, int K_, int ROT_ = 0, bool ABLK_ = false>
struct DenseOrder {
    static constexpr int nM = M_ / BM, nN = N_ / BM, nwg = nM * nN, K = K_;
    int G, c;
    __device__ void init(int G_, int c_) { G = G_; c = c_; }
    __device__ __forceinline__ bool next(int i, Unit& u) const {
        const long L = (long)i * G + c; if (L >= nwg) return false;
        int wgid = (int)L; { const int q = nwg / 8, r = nwg % 8, xcd = wgid % 8, off = wgid / 8; wgid = (xcd < r ? xcd * (q + 1) : r * (q + 1) + (xcd - r) * q) + off; }
        const int nig = 8 * nN, gid = wgid / nig, fm = gid * 8, gsz = (nM - fm) < 8 ? (nM - fm) : 8;
        u.pm = fm + ((wgid % nig) % gsz); u.pn = ((wgid % nig) / gsz + ROT_) % nN; u.arow0 = u.pm * BM; u.e = 0; u.nvalid = BM; u.lrow0 = 0; u.boff = (size_t)u.pn * BM * K * 2; return true;
    }
    __device__ __forceinline__ int unit_nt(const Unit&) const { return K_ / BK; }
    __device__ __forceinline__ size_t a_kstep() const { return ABLK_ ? (size_t)2048 : (size_t)(BK * 2); }
    __device__ __forceinline__ void a_off(const Unit& u, const int (&R)[2], const int (&C)[2], unsigned (&off)[2][2]) const {
#pragma unroll
        for (int h = 0; h < 2; ++h)
#pragma unroll
            for (int i = 0; i < 2; ++i) { const int row = u.arow0 + h * HALF + R[i];
                off[h][i] = ABLK_ ? (unsigned)((((row >> 4) * (K >> 5) + (C[i] >> 5)) << 10) + ((row & 15) << 6) + ((C[i] & 31) << 1)) : (unsigned)(((size_t)row * K + C[i]) * 2); }
    }
};
struct MoeOrder {
    const LAS int* tcum; const LAS int* cnt; const LAS int* texp; const int* sorted; int nNsh, G, c, K; size_t estride; bool gather, split;
    __device__ __forceinline__ bool next(int i, Unit& u) const {
        const int NT = tcum[NEXP], U = NT << nNsh; int L = i * G + c, tail = 0, koff = 0;
        if (split && (G & 3) == 0) {
            const int Fr = U / G, Lf = Fr * G, T = U - Lf;
            if (i >= Fr) {
                const int s = (T == 0 || 2 * T > G) ? 1 : (4 * T > G ? 2 : 4);
                const int Ls = (i - Fr) * G + c; if (Ls >= T * s) return false;
                const int kq = (Ls >= T ? 1 : 0) + (Ls >= 2 * T ? 1 : 0) + (Ls >= 3 * T ? 1 : 0);
                L = Lf + Ls - kq * T;
                if (s > 1) { tail = kq | (s << 4) | (((L >> nNsh) - (Lf >> nNsh)) << 8); koff = kq * ((K >> 6) >> (s >> 1)) * 2048; }
            }
        } else if (L >= U) return false;
        const int rt = L >> nNsh; const int pn_ = L & ((1 << nNsh) - 1); u.pn = pn_ | (tail << 4); u.pm = rt;
        const int e = texp[rt];
        u.e = e; u.lrow0 = (rt - tcum[e]) * BM; u.nvalid = min(BM, cnt[e] - u.lrow0); u.arow0 = rt * BM;
        u.boff = (size_t)e * estride + (size_t)pn_ * BM * K * 2 + (size_t)koff; return true;
    }
    __device__ __forceinline__ int unit_nt(const Unit& u) const { return (K >> 6) >> (((u.pn >> 8) & 15) >> 1); }
    __device__ __forceinline__ void a_off(const Unit& u, const int (&R)[2], const int (&C)[2], unsigned (&off)[2][2]) const {
#pragma unroll
        for (int h = 0; h < 2; ++h)
#pragma unroll
            for (int i = 0; i < 2; ++i) {
                const int r = h * HALF + R[i];
                int row;
                if (gather) { const int rr = r < u.nvalid ? r : 0; row = sorted[u.e * TT + u.lrow0 + rr] >> 2; off[h][i] = (unsigned)(((size_t)row * K + C[i]) * 2); }
                else { row = u.arow0 + r; off[h][i] = (unsigned)((((row >> 4) * (K >> 5) + (C[i] >> 5)) << 10) + ((row & 15) << 6) + ((C[i] & 31) << 1)) + (unsigned)(((u.pn >> 4) & 15) * ((K >> 6) >> (((u.pn >> 8) & 15) >> 1)) * 2048); }
            }
    }
    __device__ __forceinline__ size_t a_kstep() const { return gather ? (size_t)(BK * 2) : (size_t)2048; }
};

__device__ __forceinline__ unsigned cvt_pk_bf16(float lo, float hi) { f32x2_t v = {lo, hi}; bf16x2_t b = __builtin_convertvector(v, bf16x2_t); return __builtin_bit_cast(unsigned, b); }

__device__ __forceinline__ u32x4 dpp_swap1(u32x4 v) { u32x4 r; r.x = (unsigned)__builtin_amdgcn_mov_dpp((int)v.x, 0xB1, 0xf, 0xf, true); r.y = (unsigned)__builtin_amdgcn_mov_dpp((int)v.y, 0xB1, 0xf, 0xf, true);
    r.z = (unsigned)__builtin_amdgcn_mov_dpp((int)v.z, 0xB1, 0xf, 0xf, true); r.w = (unsigned)__builtin_amdgcn_mov_dpp((int)v.w, 0xB1, 0xf, 0xf, true); return r; }
__device__ __forceinline__ void store_pair(bf16_t* pe, bf16_t* po, bool odd, u32x4 w0, u32x4 w1, bool oke, bool oko) {
    const u32x4 rcv = dpp_swap1(odd ? w0 : w1);
    const int c = odd ? 32 : 0;
    if (oke) *(u32x4*)(pe + c) = odd ? rcv : w0;
    if (oko) *(u32x4*)(po + c) = odd ? w1 : rcv;
}
constexpr int PF_OFF = 131072 + 10240, PF_BYTES = 3072;
struct EpiInproj {
    static constexpr bool PERM = true, PREFETCH = false, MIDSCALE = false;
    bf16_t* O; float* DT; const float* dt_bias; bf16_t* QKV;
    __device__ __forceinline__ void operator()(const f32x4 (&acc)[2][2][4][2], const Unit& u, int wr, int wc, int fr, int fq, const LAS unsigned char*) const {
        const int row0 = u.arow0 + wr * 64 + fr;
        if (u.pn < NPROJ / BM) {
            const float sc = (u.pn < 4) ? 0.125f * 1.4426950408889634f : 1.f;
            const int col0 = u.pn * BM + wc * 64 + 8 * fq; const bool odd = (fr & 1) != 0; const bool qkv_tile = u.pn < 12;
#pragma unroll
            for (int ai = 0; ai < 2; ++ai)
#pragma unroll
                for (int m = 0; m < 4; ++m) { const int re_ = row0 - (odd ? 1 : 0) + ai * HALF + m * 16;
                    bf16_t* rowe = qkv_tile ? QKV + ((size_t)(u.pn * 4 + wc) * TT + re_) * 64 + 8 * fq : O + (size_t)re_ * NPROJ + col0;
                    u32x4 w[2];
#pragma unroll
                    for (int bj = 0; bj < 2; ++bj) { const f32x4 v0 = acc[ai][bj][m][0] * sc, v1 = acc[ai][bj][m][1] * sc;
                        w[bj].x = cvt_pk_bf16(v0[0], v0[1]); w[bj].y = cvt_pk_bf16(v0[2], v0[3]); w[bj].z = cvt_pk_bf16(v1[0], v1[1]); w[bj].w = cvt_pk_bf16(v1[2], v1[3]); }
                    store_pair(rowe, rowe + (qkv_tile ? 64 : NPROJ), odd, w[0], w[1], true, true); }
        } else if (wc == 0) {
            const int c0 = 8 * fq; const f32x4 b0 = *(const f32x4*)(dt_bias + c0), b1 = *(const f32x4*)(dt_bias + c0 + 4);
#pragma unroll
            for (int ai = 0; ai < 2; ++ai)
#pragma unroll
                for (int m = 0; m < 4; ++m) { const int t_ = row0 + ai * HALF + m * 16; float* colp = DT + ((size_t)(t_ >> 7) * 32 + c0) * 128 + (t_ & 127);
                    f32x4 v0 = acc[ai][0][m][0] + b0, v1 = acc[ai][0][m][1] + b1;
#pragma unroll
                    for (int j = 0; j < 4; ++j) {
                        { const float e = __expf(v0[j]); v0[j] = v0[j] > 20.f ? v0[j] : (v0[j] < -9.f ? e * (1.f - 0.5f * e) : __logf(1.f + e)); }
                        { const float e = __expf(v1[j]); v1[j] = v1[j] > 20.f ? v1[j] : (v1[j] < -9.f ? e * (1.f - 0.5f * e) : __logf(1.f + e)); } }
#pragma unroll
                    for (int j = 0; j < 4; ++j) { colp[j * 128] = v0[j]; colp[(4 + j) * 128] = v1[j]; } }
        }
    }
};
struct EpiBf16 {
    static constexpr bool PERM = true, PREFETCH = false, MIDSCALE = true;
    bf16_t* O; int ldc; const float* rr;
    __device__ __forceinline__ void operator()(const f32x4 (&acc)[2][2][4][2], const Unit& u, int wr, int wc, int fr, int fq, const LAS unsigned char*) const {
        const int row0 = u.arow0 + wr * 64 + fr, col0 = u.pn * BM + wc * 64 + 8 * fq; const bool odd = (fr & 1) != 0;
#pragma unroll
        for (int ai = 0; ai < 2; ++ai)
#pragma unroll
            for (int m = 0; m < 4; ++m) { bf16_t* rowe = O + (size_t)(row0 - (odd ? 1 : 0) + ai * HALF + m * 16) * ldc + col0;
                u32x4 w[2];
#pragma unroll
                for (int bj = 0; bj < 2; ++bj) { const f32x4 v0 = acc[ai][bj][m][0], v1 = acc[ai][bj][m][1];
                    w[bj].x = cvt_pk_bf16(v0[0], v0[1]); w[bj].y = cvt_pk_bf16(v0[2], v0[3]); w[bj].z = cvt_pk_bf16(v1[0], v1[1]); w[bj].w = cvt_pk_bf16(v1[2], v1[3]); }
                store_pair(rowe, rowe + ldc, odd, w[0], w[1], true, true); }
    }
};
struct EpiSwiglu {
    static constexpr bool PERM = true, PREFETCH = true, MIDSCALE = false;
    bf16_t* ACT; const float* b_gu;
    __device__ __forceinline__ void prefetch(const Unit& u, LAS unsigned char* pf, int wid, int lane) const {
        if (wid == 0) __builtin_amdgcn_global_load_lds((const unsigned*)(b_gu + (size_t)u.e * 2048 + (lane >> 5) * FF + u.pn * HALF + 4 * (lane & 31)), (LAS unsigned*)pf, 16, 0, 0);
    }
    __device__ __forceinline__ void operator()(const f32x4 (&acc)[2][2][4][2], const Unit& u, int wr, int wc, int fr, int fq, const LAS unsigned char* pf) const {
        const int rb0 = (u.arow0 >> 4) + wr * 4, cb = u.pn * 4 + wc;
        const LAS float* bg = (const LAS float*)pf + wc * 32 + 8 * fq;
        f32x4 bgate[2], bup[2];
#pragma unroll
        for (int n = 0; n < 2; ++n) { bgate[n] = *(const LAS f32x4*)(bg + 4 * n); bup[n] = *(const LAS f32x4*)(bg + HALF + 4 * n) + 1.f; }
#pragma unroll
        for (int ai = 0; ai < 2; ++ai)
#pragma unroll
            for (int m = 0; m < 4; ++m) {
                float a[8];
#pragma unroll
                for (int n = 0; n < 2; ++n)
#pragma unroll
                    for (int j = 0; j < 4; ++j) {
                        const float gate = __builtin_amdgcn_fmed3f(acc[ai][0][m][n][j] + bgate[n][j], -INFINITY, 7.f), up1 = __builtin_amdgcn_fmed3f(acc[ai][1][m][n][j] + bup[n][j], -6.f, 8.f);
                        a[4 * n + j] = up1 * gate * __builtin_amdgcn_rcpf(1.f + __builtin_amdgcn_exp2f((-1.702f * 1.44269504f) * gate));
                    }
                u32x4 w; w.x = cvt_pk_bf16(a[0], a[1]); w.y = cvt_pk_bf16(a[2], a[3]); w.z = cvt_pk_bf16(a[4], a[5]); w.w = cvt_pk_bf16(a[6], a[7]);
                *(u32x4*)(ACT + ((size_t)(rb0 + ai * 8 + m) * 32 + cb) * 512 + fr * 32 + 8 * fq) = w;
            }
    }
};
struct EpiDown {
    static constexpr bool PERM = true, PREFETCH = true, MIDSCALE = false;
    bf16_t* Y; const float* b_dn; const int* sorted; const float* sortw; unsigned* flg;
    __device__ __forceinline__ void prefetch(const Unit& u, LAS unsigned char* pf, int wid, int lane) const {
        if (wid == 0) __builtin_amdgcn_global_load_lds((const unsigned*)(sorted + (size_t)u.e * TT + u.lrow0 + 4 * lane), (LAS unsigned*)pf, 16, 0, 0);
        else if (wid == 1) __builtin_amdgcn_global_load_lds((const unsigned*)(sortw + (size_t)u.e * TT + u.lrow0 + 4 * lane), (LAS unsigned*)(pf + 1024), 16, 0, 0);
        else if (wid == 2) __builtin_amdgcn_global_load_lds((const unsigned*)(b_dn + (size_t)u.e * DM + (u.pn & 15) * BM + 4 * lane), (LAS unsigned*)(pf + 2048), 16, 0, 0);
    }
    __device__ __forceinline__ void operator()(const f32x4 (&acc)[2][2][4][2], const Unit& u, int wr, int wc, int fr, int fq, const LAS unsigned char* pf) const {
        const int col0 = (u.pn & 15) * BM + wc * 64 + 8 * fq; const bool odd = (fr & 1) != 0;
        const LAS float* bp = (const LAS float*)(pf + 2048) + wc * 64 + 8 * fq;
        f32x4 bv[2][2];
#pragma unroll
        for (int bj = 0; bj < 2; ++bj)
#pragma unroll
            for (int n = 0; n < 2; ++n) bv[bj][n] = *(const LAS f32x4*)(bp + bj * 32 + 4 * n);
        int slot[8]; float wgt[8];
#pragma unroll
        for (int q = 0; q < 8; ++q) { const int r = (q >> 2) * HALF + wr * 64 + (q & 3) * 16 + fr; slot[q] = ((const LAS int*)pf)[r]; wgt[q] = ((const LAS float*)(pf + 1024))[r]; }
        const int tl = __builtin_amdgcn_readfirstlane(u.pn >> 4);
        if (tl) {
            const int kq = tl & 15, crow0 = (tl >> 8) * BM; int frx = fr; asm volatile("" : "+v"(frx));
            if (kq == 0) { if (wc == 0 && fq == 0) {
#pragma unroll
                    for (int q = 0; q < 8; ++q) { const int r = (q >> 2) * HALF + wr * 64 + (q & 3) * 16 + frx; if (r < u.nvalid) flg[slot[q]] = ((unsigned)(tl & 0xf0) << 20) | (unsigned)(crow0 + r); } } }
            else {
                const int qb = __builtin_amdgcn_readfirstlane(QBASE_ROWS + (kq - 1) * QROWS + crow0 + wr * 64);
#pragma unroll
                for (int q = 0; q < 8; ++q) slot[q] = qb + (q >> 2) * HALF + (q & 3) * 16 + frx;
#pragma unroll
                for (int bj = 0; bj < 2; ++bj)
#pragma unroll
                    for (int n = 0; n < 2; ++n) bv[bj][n] = (f32x4){0.f, 0.f, 0.f, 0.f};
            }
        }
#pragma unroll
        for (int ai = 0; ai < 2; ++ai)
#pragma unroll
            for (int m = 0; m < 4; ++m) {
                const int r = ai * HALF + wr * 64 + m * 16 + fr, re = r & ~1;
                const float w = wgt[ai * 4 + m];
                const int so = slot[ai * 4 + m], sp = __builtin_amdgcn_mov_dpp(so, 0xB1, 0xf, 0xf, true);
                u32x4 o[2];
#pragma unroll
                for (int bj = 0; bj < 2; ++bj) { const f32x4 v0 = (acc[ai][bj][m][0] + bv[bj][0]) * w, v1 = (acc[ai][bj][m][1] + bv[bj][1]) * w;
                    o[bj].x = cvt_pk_bf16(v0[0], v0[1]); o[bj].y = cvt_pk_bf16(v0[2], v0[3]); o[bj].z = cvt_pk_bf16(v1[0], v1[1]); o[bj].w = cvt_pk_bf16(v1[2], v1[3]); }
                store_pair(Y + (size_t)(odd ? sp : so) * DM + col0, Y + (size_t)(odd ? so : sp) * DM + col0, odd, o[0], o[1], re < u.nvalid, re + 1 < u.nvalid);
            }
    }
};

template <class Epi, class Sched, bool ALIGN_EPI>
__device__ __forceinline__ void gemm_phase(LAS unsigned char* lds, const Gemm g, const Sched& S, const Epi& E, int wid) {
    const int lane = lane_id_fresh(), tid = wid * 64 + lane, wr = wid >> 2, wc = wid & 3, fr = lane & 15, fq = lane >> 4;
    const int K = g.K, nt = K / BK;
    int RA[2], CA[2]; unsigned voffB[2];
#pragma unroll
    for (int i = 0; i < 2; ++i) { int R, C; stage_rc(tid * 16 + i * 8192, R, C);
        RA[i] = R; CA[i] = C; voffB[i] = (unsigned)((((R >> 4) * (K >> 5) + (C >> 5)) << 10) + ((R & 15) << 6) + ((C & 31) << 1)); }
    const size_t kstep = (size_t)2048, kstepA = S.a_kstep();
    const size_t hstep = (size_t)HALF * K * 2;
    const unsigned ldsw = (unsigned)wid * 1024u;
    const int aoff = lds_byte(wr * 64 + fr, fq * 8), boff = lds_byte(wc * 32 + fr, fq * 8);
#define PG8_SA(b, h) (((b) * 2 + (h)) * HTB)
#define PG8_SB(b, h) ((4 + (b) * 2 + (h)) * HTB)
#define PG8_STAGE(bufoff, gbase, voff) do { _Pragma("unroll") for (int _i = 0; _i < 2; ++_i) \
        __builtin_amdgcn_global_load_lds((const unsigned*)((const char*)(gbase) + (voff)[_i]), (LAS unsigned*)(lds + (bufoff) + ldsw + _i * 8192), 16, 0, 0); } while (0)
#define PG8_LDA(dst, b, h) do { _Pragma("unroll") for (int m = 0; m < 4; ++m) _Pragma("unroll") for (int k = 0; k < 2; ++k) dst[m][k] = *(const LAS bf16x8*)(lds + PG8_SA(b, h) + aoff + m * 2048 + k * 1024); } while (0)
#define PG8_LDB(dst, b, h) do { _Pragma("unroll") for (int n = 0; n < 2; ++n) _Pragma("unroll") for (int k = 0; k < 2; ++k) dst[n][k] = *(const LAS bf16x8*)(lds + PG8_SB(b, h) + boff + n * 2048 + k * 1024); } while (0)
#define PG8_MMA(ai, bj, At, Bt) do { __builtin_amdgcn_s_setprio(1); _Pragma("unroll") for (int m = 0; m < 4; ++m) _Pragma("unroll") for (int n = 0; n < 2; ++n) _Pragma("unroll") for (int k = 0; k < 2; ++k) \
        acc[ai][bj][m][n] = __builtin_amdgcn_mfma_f32_16x16x32_bf16(Bt[n][k], At[m][k], acc[ai][bj][m][n], 0, 0, 0); __builtin_amdgcn_s_setprio(0); } while (0)
#define PG8_WAIT_V(n) asm volatile("s_waitcnt vmcnt(" #n ")" ::: "memory")
#define PG8_WAIT_L(n) asm volatile("s_waitcnt lgkmcnt(" #n ")" ::: "memory")
#define PG8_BAR __builtin_amdgcn_s_barrier()
#define PG8_SCHED __builtin_amdgcn_sched_barrier(0)
    Unit cur, nxt; int ui = 0;
    if (!S.next(0, cur)) return;
    f32x4 acc[2][2][4][2];
#pragma unroll
    for (int a = 0; a < 2; ++a)
#pragma unroll
        for (int b = 0; b < 2; ++b)
#pragma unroll
            for (int m = 0; m < 4; ++m)
#pragma unroll
                for (int n = 0; n < 2; ++n) acc[a][b][m][n] = (f32x4){0.f, 0.f, 0.f, 0.f};
    bf16x8 At[4][2], B0[2][2], B1[2][2];
    unsigned coffA[2][2], noffA[2][2];
    S.a_off(cur, RA, CA, coffA);
    if constexpr (Epi::PREFETCH) E.prefetch(cur, lds + PF_OFF, wid, lane);
    const char* gA = (const char*)g.A; const char* cB = (const char*)g.Bt + cur.boff;
    PG8_STAGE(PG8_SB(0, 0), cB, voffB); PG8_STAGE(PG8_SB(0, 1), cB + hstep, voffB); PG8_STAGE(PG8_SA(0, 0), gA, coffA[0]); PG8_STAGE(PG8_SA(0, 1), gA, coffA[1]);
    if (wr == 1) PG8_BAR;
    PG8_WAIT_V(2); PG8_BAR;
    PG8_STAGE(PG8_SB(1, 0), cB + kstep, voffB); PG8_STAGE(PG8_SA(1, 0), gA + kstepA, coffA[0]); PG8_STAGE(PG8_SB(1, 1), cB + hstep + kstep, voffB);
    PG8_WAIT_V(6); PG8_BAR;
    for (;;) {
        const bool has_next = S.next(ui + 1, nxt);
        if (has_next) S.a_off(nxt, RA, CA, noffA);
        else {
#pragma unroll
            for (int h = 0; h < 2; ++h)
#pragma unroll
                for (int i = 0; i < 2; ++i) noffA[h][i] = coffA[h][i];
        }
        const char* nB = has_next ? (const char*)g.Bt + nxt.boff : cB;
        const int ntu = __builtin_amdgcn_readfirstlane(S.unit_nt(cur));
        for (int t = 0; t < ntu; t += 2) {
            const bool last = (t == ntu - 2);
            if constexpr (Epi::MIDSCALE) {
                if (t == nt / 2) {
                    int frx = fr; asm volatile("" : "+v"(frx));
                    const float* rb = E.rr + __builtin_amdgcn_readfirstlane(cur.arow0) + wr * 64 + frx;
#pragma unroll
                    for (int a = 0; a < 2; ++a)
#pragma unroll
                        for (int m = 0; m < 4; ++m) { const float rv = rsqrtf((rb[a * HALF + m * 16] + rb[TT + a * HALF + m * 16]) * (1.f / DM) + RMS_EPS);
#pragma unroll
                            for (int b = 0; b < 2; ++b)
#pragma unroll
                                for (int n = 0; n < 2; ++n) acc[a][b][m][n] = acc[a][b][m][n] * rv; }
                }
            }
            const char* a1 = gA + (size_t)(t + 1) * kstepA;
            const char* a2 = last ? gA : gA + (size_t)(t + 2) * kstepA; const char* b2 = last ? nB : cB + (size_t)(t + 2) * kstep;
            const char* a3 = a2 + kstepA; const char* b3 = b2 + kstep;
            unsigned o2[2][2];
#pragma unroll
            for (int h = 0; h < 2; ++h)
#pragma unroll
                for (int i = 0; i < 2; ++i) o2[h][i] = last ? noffA[h][i] : coffA[h][i];
            PG8_LDB(B0, 0, 0); PG8_LDB(B1, 0, 1); PG8_SCHED; PG8_LDA(At, 0, 0); PG8_STAGE(PG8_SA(1, 1), a1, coffA[1]);
            PG8_WAIT_V(8); PG8_WAIT_L(0); PG8_BAR; PG8_MMA(0, 0, At, B0); PG8_MMA(0, 1, At, B1); PG8_BAR; PG8_SCHED;
            PG8_LDA(At, 0, 1); PG8_STAGE(PG8_SB(0, 0), b2, voffB); PG8_STAGE(PG8_SB(0, 1), b2 + hstep, voffB); PG8_STAGE(PG8_SA(0, 0), a2, o2[0]);
            PG8_WAIT_V(8); PG8_WAIT_L(0); PG8_BAR; PG8_MMA(1, 0, At, B0); PG8_MMA(1, 1, At, B1); PG8_BAR; PG8_SCHED;
            PG8_LDB(B0, 1, 0); PG8_LDB(B1, 1, 1); PG8_SCHED; PG8_LDA(At, 1, 0); PG8_STAGE(PG8_SA(0, 1), a2, o2[1]);
            PG8_WAIT_V(8); PG8_WAIT_L(0); PG8_BAR; PG8_MMA(0, 0, At, B0); PG8_MMA(0, 1, At, B1); PG8_BAR; PG8_SCHED;
            PG8_LDA(At, 1, 1); PG8_STAGE(PG8_SB(1, 0), b3, voffB); PG8_STAGE(PG8_SB(1, 1), b3 + hstep, voffB); PG8_STAGE(PG8_SA(1, 0), a3, o2[0]);
            PG8_WAIT_V(8); PG8_WAIT_L(0); PG8_BAR; PG8_MMA(1, 0, At, B0); PG8_MMA(1, 1, At, B1); PG8_BAR; PG8_SCHED;
        }
        if constexpr (ALIGN_EPI) { if (wr == 0) PG8_BAR; }
        if constexpr (Epi::PREFETCH) { if (has_next) E.prefetch(nxt, lds + PF_OFF + ((ui + 1) & 1) * PF_BYTES, wid, lane_id_fresh()); }
        E(acc, cur, wr, wc, fr, fq, lds + PF_OFF + (ui & 1) * PF_BYTES);
        if (!has_next) break;
#pragma unroll
        for (int a = 0; a < 2; ++a)
#pragma unroll
            for (int b = 0; b < 2; ++b)
#pragma unroll
                for (int m = 0; m < 4; ++m)
#pragma unroll
                    for (int n = 0; n < 2; ++n) acc[a][b][m][n] = (f32x4){0.f, 0.f, 0.f, 0.f};
        cur = nxt; cB = nB; ++ui;
#pragma unroll
        for (int h = 0; h < 2; ++h)
#pragma unroll
            for (int i = 0; i < 2; ++i) coffA[h][i] = noffA[h][i];
        if constexpr (ALIGN_EPI) { if (wr == 1) PG8_BAR; }
    }
    PG8_WAIT_V(0);
    if constexpr (!ALIGN_EPI) { if (wr == 0) PG8_BAR; }
    PG8_BAR;
#undef PG8_SA
#undef PG8_SB
#undef PG8_STAGE
#undef PG8_LDA
#undef PG8_LDB
#undef PG8_MMA
#undef PG8_WAIT_V
#undef PG8_WAIT_L
#undef PG8_BAR
#undef PG8_SCHED
}
}

#define XB_TMO      128
#define XB_XCNT(j)  (256  + 64 * (j))
#define XB_XSUB(j)  (1280 + 64 * (j))
#define XB_XGEN(j)  (2304 + 64 * (j))
#define XB_TOP      3328
#define XB_TOPGEN   3392
#define XCD_BAR_WORDS 3456
#define XB_SPIN_CAP (1u << 18)
__device__ __forceinline__ unsigned xb_ld(unsigned* p)              { return __hip_atomic_load(p, __ATOMIC_RELAXED, __HIP_MEMORY_SCOPE_AGENT); }
__device__ __forceinline__ unsigned xb_add(unsigned* p, unsigned v) { return __hip_atomic_fetch_add(p, v, __ATOMIC_RELAXED, __HIP_MEMORY_SCOPE_AGENT); }
__device__ __forceinline__ unsigned xb_xcc_id() { return (unsigned)__builtin_amdgcn_s_getreg((3 << 11) | 20) & 0xFu; }
#define XB_SPIN(cond, bar) do { unsigned _sp = 0; while (cond) { __builtin_amdgcn_s_sleep(1); \
    if ((++_sp & 255u) == 0u) { if (xb_ld(&(bar)[XB_TMO])) break; if (_sp > XB_SPIN_CAP) { atomicAdd(&(bar)[XB_TMO], 1u); break; } } } } while (0)
struct XcdBarrier { unsigned* bar; unsigned x; volatile LAS unsigned* st; };
__device__ __forceinline__ XcdBarrier xcd_barrier_post(unsigned* bar, volatile LAS unsigned* st) {
    XcdBarrier b; b.bar = bar; b.x = xb_xcc_id(); b.st = st;
    if (threadIdx.x == 0) (void)xb_add(&bar[XB_XCNT(b.x)], 1u);
    return b;
}
__device__ __forceinline__ void xcd_barrier_complete(unsigned* bar, unsigned x, unsigned& nloc, unsigned& nx) {
    const unsigned G = gridDim.x * gridDim.y * gridDim.z;
    unsigned sum, cnt, mine, sp = 0u;
    for (;;) {
        sum = 0u; cnt = 0u; mine = 0u;
#pragma unroll
        for (unsigned j = 0; j < 16; ++j) { const unsigned c = xb_ld(&bar[XB_XCNT(j)]); sum += c; cnt += (c > 0u) ? 1u : 0u; mine = (j == x) ? c : mine; }
        if (sum == G) break;
        __builtin_amdgcn_s_sleep(1);
        if ((++sp & 255u) == 0u) { if (xb_ld(&bar[XB_TMO])) break; if (sp > XB_SPIN_CAP) { atomicAdd(&bar[XB_TMO], 1u); break; } }
    }
    nloc = mine > 0u ? mine : 1u; nx = cnt > 0u ? cnt : 1u;
}
__device__ __forceinline__ void xcd_barrier(const XcdBarrier& b, int wave) {
    asm volatile("s_waitcnt vmcnt(0)" ::: "memory");
    __syncthreads();
    if (wave == 0 && lane_id_fresh() == 0) {
        unsigned* bar = b.bar;
        __builtin_amdgcn_s_waitcnt(0);
        unsigned nloc = b.st[0], nx = b.st[1];
        if (nloc == 0u) { xcd_barrier_complete(bar, b.x, nloc, nx); b.st[0] = nloc; b.st[1] = nx; }
        const unsigned old = xb_add(&bar[XB_XSUB(b.x)], 1u);
        const unsigned gen = old / nloc;
        if (old + 1u == (gen + 1u) * nloc) {
            __builtin_amdgcn_fence(__ATOMIC_RELEASE, "agent");
            asm volatile("s_waitcnt vmcnt(0)" ::: "memory");
            const unsigned og = xb_add(&bar[XB_TOP], 1u);
            const unsigned tg = og / nx;
            if (og + 1u == (tg + 1u) * nx) xb_add(&bar[XB_TOPGEN], 1u);
            else XB_SPIN(xb_ld(&bar[XB_TOPGEN]) == tg, bar);
            __builtin_amdgcn_fence(__ATOMIC_ACQUIRE, "agent");
            xb_add(&bar[XB_XGEN(b.x)], 1u);
            asm volatile("s_waitcnt vmcnt(0)" ::: "memory");
        } else {
            XB_SPIN(xb_ld(&bar[XB_XGEN(b.x)]) == gen, bar);
            __builtin_amdgcn_fence(__ATOMIC_ACQUIRE, "agent");
            asm volatile("s_waitcnt vmcnt(0)" ::: "memory");
        }
    }
    __syncthreads();
}

struct Ctx {
    LAS unsigned char* lds; int wave, G, bid;
    const float *x, *c, *w_ada, *b_ada, *g_pre_mix, *g_post_mix, *w_in, *conv_w, *conv_b, *dt_bias, *a_log, *d_skip, *g_ssd, *w_out, *g_pre_ffn, *g_post_ffn, *w_router, *b_router, *w_gu, *b_gu, *w_dn, *b_dn;
    float* out; unsigned* ctl; float* mod; unsigned* FLG; bf16_t* QKV;
    bf16_t *WIN, *WOUT, *WGU, *WDN, *H, *PROJ, *XC, *MIXIN, *ACT, *YSLOT;
    float *DT, *TOPW, *CUM, *CHDEC, *LSE, *SORTW, *RR; int* SORT; bf16_t *STATES, *OPART, *HPREV, *WRT, *MIX, *RES;
};

struct P0Item { const float* src; bf16_t* dst; int N, K, gu, kd; };
__device__ __forceinline__ void p0_load(const P0Item& d, int lane, f32x4 (&v)[8]) {
    const float* p = d.src + (size_t)(lane >> 3) * d.N + 4 * (lane & 7);
#pragma unroll
    for (int j = 0; j < 8; ++j) v[j] = __builtin_nontemporal_load((const f32x4*)(p + (size_t)(8 * j) * d.N));
}
__device__ __forceinline__ void p0_emit(const P0Item& d, int n0, int lane, LAS float* scr, const f32x4 (&v)[8]) {
    LAS float* w = scr + (lane >> 3) * 33 + 4 * (lane & 7);
#pragma unroll
    for (int j = 0; j < 8; ++j) { w[(8 * j) * 33] = v[j].x; w[(8 * j) * 33 + 1] = v[j].y; w[(8 * j) * 33 + 2] = v[j].z; w[(8 * j) * 33 + 3] = v[j].w; }
    LDS_WAIT(); asm volatile("" ::: "memory");
    const int c = lane & 7;
    int rho0 = n0;
    if (d.gu) { const int jj = n0 < FF ? n0 : n0 - FF; rho0 = (jj >> 7) * 256 + ((jj & 127) >> 5) * 64 + (n0 < FF ? 0 : 32); }
    const int KB = d.K >> 5, q = (rho0 >> 6) & 3;
    bf16_t* tb = d.dst + (size_t)(rho0 >> 8) * 256 * d.K + (size_t)((rho0 >> 5) & 1) * 128 * d.K;
#pragma unroll
    for (int j = 0; j < 4; ++j) { const int n = (lane >> 3) + 8 * j; const LAS float* s = scr + (8 * c) * 33 + n;
        u32x4 o; o.x = pk2(s[0 * 33], s[1 * 33]); o.y = pk2(s[2 * 33], s[3 * 33]); o.z = pk2(s[4 * 33], s[5 * 33]); o.w = pk2(s[6 * 33], s[7 * 33]);
        *(GAS u32x4*)(tb + (size_t)((2 * q + ((lane >> 5) & 1)) * KB + 2 * d.kd + (c >> 2)) * 512 + (4 * j + ((lane >> 3) & 3)) * 32 + 8 * (c & 3)) = o; }
    LDS_WAIT(); asm volatile("" ::: "memory");
}

__device__ __forceinline__ void p0_prologue(const Ctx& F) {
    const int f_lane = lane_id_fresh();
    {
        LAS float* red = (LAS float*)(F.lds);
        for (int it = F.bid; it < 96; it += F.G) {
            const int col = it * 64 + f_lane; float a0 = 0.f, a1 = 0.f;
#pragma unroll 16
            for (int k = F.wave * 128; k < F.wave * 128 + 128; ++k) { const float w = __builtin_nontemporal_load(F.w_ada + (size_t)k * 6144 + col); a0 += siluf(F.c[k]) * w; a1 += siluf(F.c[DM + k]) * w; }
            red[(F.wave * 2 + 0) * 64 + f_lane] = a0; red[(F.wave * 2 + 1) * 64 + f_lane] = a1;
            __syncthreads();
            if (F.wave < 2) { float s = F.b_ada[col];
#pragma unroll
                for (int w = 0; w < 8; ++w) s += red[(w * 2 + F.wave) * 64 + f_lane];
                F.mod[F.wave * 6144 + col] = s; }
            asm volatile("s_waitcnt vmcnt(0)" ::: "memory");
            __syncthreads();
            if (F.wave == 0 && f_lane == 0) {
                __builtin_amdgcn_fence(__ATOMIC_RELEASE, "agent"); asm volatile("s_waitcnt vmcnt(0)" ::: "memory");
                __hip_atomic_fetch_add(F.ctl + CW_MODCNT, 1u, __ATOMIC_RELAXED, __HIP_MEMORY_SCOPE_AGENT); }
        }
    }
    for (int i = F.bid * NTHREADS + F.wave * 64 + f_lane; i < DM * NEXP; i += F.G * NTHREADS) { const int k = i >> 5, e = i & 31; const float w = F.w_router[i];
        const bf16_t hi = f2bf(w); F.WRT[e * DM + k] = hi; F.WRT[NEXP * DM + e * DM + k] = f2bf(w - bf2f(hi)); }
    LAS float* scr = (LAS float*)(F.lds + F.wave * 16384);
    const int gw = F.bid * NWAVES + F.wave, NGW = F.G * NWAVES;
    constexpr int I_IN = (DM / 64) * (NPROJ_ALL / 32), I_OUT = (2048 / 64) * (DM / 32);
    constexpr int NITEMS = I_IN + I_OUT;
    auto desc = [&](int it, P0Item& d, int& n0) {
        int r = it; const float* W; bf16_t* WT; int K, N; d.gu = 0;
        if (r < I_IN) { W = F.w_in; WT = F.WIN; K = DM; N = NPROJ_ALL; }
        else { r -= I_IN; W = F.w_out; WT = F.WOUT; K = 2048; N = DM; }
        const int nblk = N / 32, kb = r / nblk, nb = r - kb * nblk; n0 = 32 * nb;
        const int kd = (W == F.w_out) ? ((kb + 16) & 31) : kb;
        d.src = W + (size_t)(64 * kb) * N + n0; d.dst = WT; d.kd = kd; d.N = N; d.K = K;
    };
    f32x4 va[8]; P0Item da; int na = 0;
    constexpr int NA = 2368;
    if (F.G > 96) {
        if (F.bid >= 96) for (int it = (F.bid - 96) * NWAVES + F.wave; it < NA; it += (F.G - 96) * NWAVES) { desc(it, da, na); p0_load(da, f_lane, va); p0_emit(da, na, f_lane, scr, va); }
        for (int it = NA + gw; it < NITEMS; it += NGW) { desc(it, da, na); p0_load(da, f_lane, va); p0_emit(da, na, f_lane, scr, va); }
    } else
        for (int it = gw; it < NITEMS; it += NGW) { desc(it, da, na); p0_load(da, f_lane, va); p0_emit(da, na, f_lane, scr, va); }
}

constexpr int FI_GU = (DM / 64) * (2048 / 32), FI_DN = (FF / 64) * (DM / 32), FILL_GU = NEXP * FI_GU, FILL_ALL = NEXP * (FI_GU + FI_DN);
__device__ __forceinline__ void merge_token(const Ctx& F, int t, int lane) {
    u32x4 v[3][2];
#pragma unroll
    for (int g = 0; g < 3; ++g) { const bf16_t* src = F.OPART + ((size_t)g * TT + t) * DM + 8 * lane; v[g][0] = __builtin_nontemporal_load((const u32x4*)src); v[g][1] = __builtin_nontemporal_load((const u32x4*)(src + 512)); }
#pragma unroll
    for (int hv = 0; hv < 2; ++hv) {
        const int hd = 8 * hv + (lane >> 3);
        const float l0 = F.LSE[(size_t)t * 16 + hd], l1 = F.LSE[((size_t)TT + t) * 16 + hd], l2 = F.LSE[((size_t)2 * TT + t) * 16 + hd];
        const float m = fmaxf(l0, fmaxf(l1, l2)), e0 = __builtin_amdgcn_exp2f(l0 - m), e1 = __builtin_amdgcn_exp2f(l1 - m), e2 = __builtin_amdgcn_exp2f(l2 - m), inv = __builtin_amdgcn_rcpf(e0 + e1 + e2);
        const float w[3] = {e0 * inv, e1 * inv, e2 * inv};
        float a[8] = {0.f, 0.f, 0.f, 0.f, 0.f, 0.f, 0.f, 0.f};
#pragma unroll
        for (int g = 0; g < 3; ++g) { const u32x4 q = v[g][hv];
            a[0] += w[g] * __uint_as_float(q.x << 16); a[1] += w[g] * __uint_as_float(q.x & 0xffff0000u); a[2] += w[g] * __uint_as_float(q.y << 16); a[3] += w[g] * __uint_as_float(q.y & 0xffff0000u);
            a[4] += w[g] * __uint_as_float(q.z << 16); a[5] += w[g] * __uint_as_float(q.z & 0xffff0000u); a[6] += w[g] * __uint_as_float(q.w << 16); a[7] += w[g] * __uint_as_float(q.w & 0xffff0000u); }
        u32x4 o; o.x = pk2(a[0], a[1]); o.y = pk2(a[2], a[3]); o.z = pk2(a[4], a[5]); o.w = pk2(a[6], a[7]);
        *(u32x4*)(F.MIXIN + (size_t)t * 2048 + 1024 + 512 * hv + 8 * lane) = o; }
}
constexpr int FQ_GU = FILL_GU / NWAVES, FQ_ALL = FILL_ALL / NWAVES, MQ_ALL = TT / (2 * NWAVES);
struct Fill { int pend, mpend, mopen, wdone, mdone; };
__device__ __forceinline__ void merge_item(const Ctx& F, int it) {
    const int lane = lane_id_fresh(), t = (it * NWAVES + F.wave) * 2;
    merge_token(F, t, lane); merge_token(F, t + 1, lane);
}
__device__ __forceinline__ void fill_item(const Ctx& F, int it) {
    const int lane = lane_id_fresh(); int r = it * NWAVES + F.wave;
    P0Item d; const float* W; bf16_t* WT; int K, N;
    if (r < FILL_GU) { const int eq = r / FI_GU, e = NEXP - 1 - eq; r -= eq * FI_GU; W = F.w_gu + (size_t)e * DM * 2048; WT = F.WGU + (size_t)e * 2048 * DM; K = DM; N = 2048; d.gu = 1; }
    else { r -= FILL_GU; const int eq = r / FI_DN, e = NEXP - 1 - eq; r -= eq * FI_DN; W = F.w_dn + (size_t)e * FF * DM; WT = F.WDN + (size_t)e * DM * FF; K = FF; N = DM; d.gu = 0; }
    const int nblk = N / 32, kb = r / nblk, nb = r - kb * nblk, n0 = 32 * nb;
    d.src = W + (size_t)(64 * kb) * N + n0; d.dst = WT; d.kd = kb; d.N = N; d.K = K;
    f32x4 v[8]; p0_load(d, lane, v); p0_emit(d, n0, lane, (LAS float*)(F.lds + F.wave * 16384), v);
}
__device__ __forceinline__ int fill_want(const Fill& fs) { if (fs.pend >= 0 || fs.mpend >= 0) return 0; if (fs.mopen && !fs.mdone) return 2; return fs.wdone ? 0 : 1; }
__device__ __forceinline__ void fill_take(Fill& fs, int want, int v) {
    if (want == 2) { if (v >= MQ_ALL) fs.mdone = 1; else fs.mpend = v; } else if (want == 1) { if (v >= FQ_ALL) fs.wdone = 1; else fs.pend = v; }
}
__device__ __forceinline__ void fill_drain(const Ctx& F, Fill& fs, int which, int limit, volatile LAS unsigned* W) {
    const bool t0 = (F.wave == 0 && lane_id_fresh() == 0);
    unsigned* q = F.ctl + (which == 2 ? CW_MQ : CW_FQ);
    for (unsigned par = 0u;; par ^= 1u) {
        const int cur = (which == 2) ? fs.mpend : fs.pend;
        if (which == 2) { if (cur < 0 && fs.mdone) break; } else { if (cur >= 0 ? cur >= limit : fs.wdone != 0) break; }
        unsigned nv = 0u;
        if (t0) nv = (unsigned)__hip_atomic_fetch_add(q, 1u, __ATOMIC_RELAXED, __HIP_MEMORY_SCOPE_AGENT);
        if (cur >= 0) { if (which == 2) { merge_item(F, cur); fs.mpend = -1; } else { fill_item(F, cur); fs.pend = -1; } }
        if (t0) W[6u + par] = nv;
        __syncthreads();
        fill_take(fs, which, (int)W[6u + par]);
    }
}
__device__ __forceinline__ void xcd_barrier_fill(const XcdBarrier& b, const Ctx& F, Fill& fs) {
    asm volatile("s_waitcnt vmcnt(0)" ::: "memory");
    __syncthreads();
    const bool t0 = (F.wave == 0 && lane_id_fresh() == 0);
    volatile LAS unsigned* W = b.st;
    unsigned* bar = b.bar;
    if (t0) {
        __builtin_amdgcn_s_waitcnt(0);
        unsigned nloc = W[0], nx = W[1];
        if (nloc == 0u) { xcd_barrier_complete(bar, b.x, nloc, nx); W[0] = nloc; W[1] = nx; }
        const unsigned old = xb_add(&bar[XB_XSUB(b.x)], 1u), gen = old / nloc;
        unsigned role = 0u, val = gen;
        if (old + 1u == (gen + 1u) * nloc) {
            __builtin_amdgcn_fence(__ATOMIC_RELEASE, "agent");
            asm volatile("s_waitcnt vmcnt(0)" ::: "memory");
            const unsigned og = xb_add(&bar[XB_TOP], 1u), tg = og / nx;
            role = 1u; val = tg;
            if (og + 1u == (tg + 1u) * nx) { xb_add(&bar[XB_TOPGEN], 1u); role = 3u; }
        }
        W[2] = role; W[3] = val; W[4] = 0u;
    }
    for (unsigned it = 0;; ++it) {
        __syncthreads();
        if (t0) {
            const unsigned role = W[2], val = W[3]; bool done;
            const int want = fill_want(fs);
            if (want) W[5] = (unsigned)__hip_atomic_fetch_add(F.ctl + (want == 2 ? CW_MQ : CW_FQ), 1u, __ATOMIC_RELAXED, __HIP_MEMORY_SCOPE_AGENT);
            if (role & 1u) done = (role & 2u) || (xb_ld(&bar[XB_TOPGEN]) != val); else done = (xb_ld(&bar[XB_XGEN(b.x)]) != val);
            if (!done && (it & 15u) == 15u) { if (xb_ld(&bar[XB_TMO])) done = true; else if (it > (1u << 16)) { atomicAdd(&bar[XB_TMO], 1u); done = true; } }
            if (done) { __builtin_amdgcn_fence(__ATOMIC_ACQUIRE, "agent"); if (role & 1u) xb_add(&bar[XB_XGEN(b.x)], 1u); }
            W[4] = done ? 1u : 0u;
        }
        __syncthreads();
        { const int want = fill_want(fs); if (want) fill_take(fs, want, (int)W[5]); }
        if (W[4]) break;
        if (fs.mpend >= 0) { merge_item(F, fs.mpend); fs.mpend = -1; } else if (fs.pend >= 0) { fill_item(F, fs.pend); fs.pend = -1; } else __builtin_amdgcn_s_sleep(4);
    }
    if (t0) asm volatile("s_waitcnt vmcnt(0)" ::: "memory");
    __syncthreads();
}

__device__ __forceinline__ void p1_prenorm(const Ctx& F) {
    const int gw = F.bid * NWAVES + F.wave, NGW = F.G * NWAVES, lane = lane_id_fresh();
    if (F.wave == 0 && lane == 0) {
        const unsigned need = (unsigned)min(96, F.G > 96 ? 96 : 96);
        unsigned sp = 0; while (__hip_atomic_load(F.ctl + CW_MODCNT, __ATOMIC_RELAXED, __HIP_MEMORY_SCOPE_AGENT) < need) { __builtin_amdgcn_s_sleep(2); if (++sp > (1u << 20)) break; }
        __builtin_amdgcn_fence(__ATOMIC_ACQUIRE, "agent"); asm volatile("s_waitcnt vmcnt(0)" ::: "memory"); }
    __syncthreads();
    f32x4 vn[2][4];
#define P1_LOAD(p_) do { const int ta_ = 2 * (p_), tb_ = ta_ + 1; _Pragma("unroll") for (int j = 0; j < 4; ++j) { \
        vn[0][j] = __builtin_nontemporal_load((const f32x4*)(F.x + (size_t)ta_ * DM + 4 * lane + 256 * j)); vn[1][j] = __builtin_nontemporal_load((const f32x4*)(F.x + (size_t)tb_ * DM + 4 * lane + 256 * j)); } } while (0)
    if (gw < TT / 2) P1_LOAD(gw);
    for (int t0 = gw; t0 < TT / 2; t0 += NGW) {
        const int tt[2] = {2 * t0, 2 * t0 + 1};
        f32x4 v[2][4]; float ss[2] = {0.f, 0.f};
#pragma unroll
        for (int q = 0; q < 2; ++q)
#pragma unroll
            for (int j = 0; j < 4; ++j) v[q][j] = vn[q][j];
        f32x4 ga[2][4], sh[2][4];
#pragma unroll
        for (int q = 0; q < 2; ++q) { const float* shift = F.mod + (tt[q] / SEQ) * 6144; const float* scale = shift + 1024;
#pragma unroll
            for (int j = 0; j < 4; ++j) { const int k = 4 * lane + 256 * j; if (q == 0 || tt[1] / SEQ != tt[0] / SEQ) { ga[q][j] = *(const f32x4*)(F.g_pre_mix + k) * (*(const f32x4*)(scale + k) + 1.f); sh[q][j] = *(const f32x4*)(shift + k); } else { ga[q][j] = ga[0][j]; sh[q][j] = sh[0][j]; } } }
        if (t0 + NGW < TT / 2) P1_LOAD(t0 + NGW);
        if (lane == 0) { *(u32x4*)(F.FLG + 4 * tt[0]) = (u32x4){0u, 0u, 0u, 0u}; *(u32x4*)(F.FLG + 4 * tt[1]) = (u32x4){0u, 0u, 0u, 0u}; }
#pragma unroll
        for (int q = 0; q < 2; ++q)
#pragma unroll
            for (int j = 0; j < 4; ++j) ss[q] += v[q][j].x * v[q][j].x + v[q][j].y * v[q][j].y + v[q][j].z * v[q][j].z + v[q][j].w * v[q][j].w;
        {
            const float r0 = rsqrtf(wave_sum(ss[0]) * (1.f / DM) + RMS_EPS), r1 = rsqrtf(wave_sum(ss[1]) * (1.f / DM) + RMS_EPS);
            const bool odd = (lane & 1) != 0; const int row = tt[odd ? 1 : 0];
            bf16_t* hb = F.H + (size_t)((row >> 4) * 32 + (lane >> 3)) * 512 + (row & 15) * 32 + 4 * (lane & 6);
#pragma unroll
            for (int j = 0; j < 4; ++j) {
                const f32x4 h0 = v[0][j] * r0 * ga[0][j] + sh[0][j], h1 = v[1][j] * r1 * ga[1][j] + sh[1][j];
                u32x2 o0, o1; o0.x = pk2(h0.x, h0.y); o0.y = pk2(h0.z, h0.w); o1.x = pk2(h1.x, h1.y); o1.y = pk2(h1.z, h1.w);
                const u32x2 snd = odd ? o0 : o1; u32x2 rcv;
                rcv.x = (unsigned)__builtin_amdgcn_mov_dpp((int)snd.x, 0xB1, 0xf, 0xf, true); rcv.y = (unsigned)__builtin_amdgcn_mov_dpp((int)snd.y, 0xB1, 0xf, 0xf, true);
                u32x4 w; if (odd) { w.x = rcv.x; w.y = rcv.y; w.z = o1.x; w.w = o1.y; } else { w.x = o0.x; w.y = o0.y; w.z = rcv.x; w.w = rcv.y; }
                *(u32x4*)(hb + (size_t)(8 * j) * 512) = w;
            }
        }
    }
#undef P1_LOAD
}
typedef short s16x4 __attribute__((ext_vector_type(4)));
typedef short v4i16_t __attribute__((ext_vector_type(4)));
__device__ __forceinline__ s16x4 tr_read(const LAS unsigned char* p) { return __builtin_bit_cast(s16x4, __builtin_amdgcn_ds_read_tr16_b64_v4i16((LAS v4i16_t*)p)); }
template <int OFF> __device__ __forceinline__ u32x2 tr_read_a(unsigned addr) { u32x2 r; asm volatile("ds_read_b64_tr_b16 %0, %1 offset:%2" : "=v"(r) : "v"(addr), "n"(OFF) : "memory"); return r; }
template <int OFF> __device__ __forceinline__ u32x4 lds_read_a(unsigned addr) { u32x4 r; asm volatile("ds_read_b128 %0, %1 offset:%2" : "=v"(r) : "v"(addr), "n"(OFF) : "memory"); return r; }
__device__ __forceinline__ void lds_wait4(u32x4 (&t)[4]) { asm volatile("s_waitcnt lgkmcnt(0)" : "+v"(t[0]), "+v"(t[1]), "+v"(t[2]), "+v"(t[3]) :: "memory"); }
__device__ __forceinline__ void tr_wait8(u32x2 (&t)[8]) { asm volatile("s_waitcnt lgkmcnt(0)" : "+v"(t[0]), "+v"(t[1]), "+v"(t[2]), "+v"(t[3]), "+v"(t[4]), "+v"(t[5]), "+v"(t[6]), "+v"(t[7]) :: "memory"); }
__device__ __forceinline__ bf16x8 cat8(s16x4 a, s16x4 b) { return (bf16x8){a[0], a[1], a[2], a[3], b[0], b[1], b[2], b[3]}; }
__device__ __forceinline__ unsigned cvtpk(float lo, float hi) { return pg8::cvt_pk_bf16(lo, hi); }
constexpr float LOG2E = 1.4426950408889634f;
__device__ __forceinline__ void p3_attention(const Ctx& F) {
    const int lane = lane_id_fresh(), wave = F.wave, tid = wave * 64 + lane, fr = lane & 15, fq = lane >> 4;
    LAS unsigned char* KIMG = F.lds;
    LAS unsigned char* VIMG = F.lds + 49152;
    const int vcu = (F.G % 8 == 0) ? (F.bid % 8) * (F.G / 8) + F.bid / 8 : F.bid;
    constexpr int NU = 2 * 16 * 3 * 32;
    const int per = (NU + F.G - 1) / F.G, u0 = vcu * per, u1 = min(NU, u0 + per);
    const int rsub = tid >> 3, c8 = tid & 7;
    LAS unsigned char* kst = KIMG + rsub * 128 + ((c8 ^ (rsub & 7)) << 4);
    LAS unsigned char* vst = VIMG + rsub * 128 + (((c8 >> 1) ^ ((rsub >> 1) & 3)) << 5) + (c8 & 1) * 16;
    u32x4 kr[6], vr[6]; bf16x8 qn_[2][2];
#define ATT_DECODE(u) const int bh_ = (u) / 96, rem_ = (u) % 96, g_ = rem_ >> 5, blk_ = rem_ & 31, sh_ = 2 * g_  , d_ = 1 << sh_, bpr_ = 32 >> sh_, \
        r_ = blk_ >> (5 - sh_), n0_ = (blk_ & (bpr_ - 1)) * 256, b_ = bh_ >> 4, h_ = bh_ & 15, Ls_ = SEQ >> sh_
#define ATT_LOAD_KV(u) do { ATT_DECODE(u); _Pragma("unroll") for (int i = 0; i < 6; ++i) { const int row = rsub + 64 * i, n = n0_ - 64 + row; \
            const bool ok = (n >= 0) && (n < Ls_); const bf16_t* src = F.QKV + ((size_t)(16 + h_) * TT + (size_t)b_ * SEQ + (size_t)(ok ? n : 0) * d_ + r_) * 64 + c8 * 8; \
            kr[i] = ok ? *(const u32x4*)src : (u32x4){0u, 0u, 0u, 0u}; vr[i] = ok ? *(const u32x4*)(src + (size_t)16 * TT * 64) : (u32x4){0u, 0u, 0u, 0u}; } } while (0)
#define ATT_LOAD_Q(u) do { ATT_DECODE(u); _Pragma("unroll") for (int qt = 0; qt < 2; ++qt) { \
              \
            const bf16_t* qp = F.QKV + ((size_t)h_ * TT + (size_t)b_ * SEQ + (size_t)(n0_ + 32 * wave + 16 * qt + (fr & ~1)) * d_ + r_) * 64 + 8 * fq + ((fr & 1) ? 32 : 0); \
            qn_[qt][0] = __builtin_nontemporal_load((const bf16x8*)qp); qn_[qt][1] = __builtin_nontemporal_load((const bf16x8*)(qp + (size_t)d_ * 64)); } } while (0)
    if (u0 < u1) { ATT_LOAD_KV(u0); } if (u0 < u1) { ATT_LOAD_Q(u0); }
    const int rq = (lane & 15) >> 2, cq = lane & 3, rl = 4 * fq + rq, xsw = (rl >> 1) & 3;
    const LAS unsigned char* vrow = VIMG + (32 * wave + rl) * 128 + ((cq ^ xsw) << 5);
    const LAS unsigned char* krow = KIMG + (32 * wave + fr) * 128;
    const int jbase = 4 * fq - 64 - fr;
    float nb[9][4];
#pragma unroll
    for (int t = 0; t < 9; ++t)
#pragma unroll
        for (int i = 0; i < 4; ++i) { const int j = 16 * t + i + jbase, aj = j < 0 ? -j : j; nb[t][i] = (aj <= 64) ? -(float)aj : -1e30f; }
#pragma unroll 1
    for (int u = u0; u < u1; ++u) {
        __syncthreads();
#pragma unroll
        for (int i = 0; i < 6; ++i) { *(LAS u32x4*)(kst + i * 64 * 128) = kr[i]; *(LAS u32x4*)(vst + i * 64 * 128) = vr[i]; }
        __syncthreads();
        if (u + 1 < u1) ATT_LOAD_KV(u + 1);
        ATT_DECODE(u);
#pragma unroll
        for (int qt = 0; qt < 2; ++qt) {
            const bool odd_ = (fr & 1) != 0;
            const u32x4 r0 = __builtin_bit_cast(u32x4, qn_[qt][0]), r1 = __builtin_bit_cast(u32x4, qn_[qt][1]);
            const u32x4 rcv = pg8::dpp_swap1(odd_ ? r0 : r1);
            qn_[qt][0] = __builtin_bit_cast(bf16x8, odd_ ? rcv : r0); qn_[qt][1] = __builtin_bit_cast(bf16x8, odd_ ? r1 : rcv); }
        const float slope2 = exp2f(-0.5f * (float)(h_ + 1)) * LOG2E * (float)d_;
        f32x4 s[2][9];
#pragma unroll
        for (int t = 0; t < 10; ++t) {
            bf16x8 kf[2];
#pragma unroll
            for (int ks = 0; ks < 2; ++ks) kf[ks] = *(const LAS bf16x8*)(krow + (16 * t) * 128 + (((4 * ks + fq) ^ (fr & 7)) << 4));
#pragma unroll
            for (int qt = 0; qt < 2; ++qt) { const int tp = t - qt; if (tp >= 0 && tp < 9) { f32x4 a = (f32x4){0.f, 0.f, 0.f, 0.f};
                a = __builtin_amdgcn_mfma_f32_16x16x32_bf16(kf[0], qn_[qt][0], a, 0, 0, 0); a = __builtin_amdgcn_mfma_f32_16x16x32_bf16(kf[1], qn_[qt][1], a, 0, 0, 0); s[qt][tp] = a; } }
        }
        if (u + 1 < u1) ATT_LOAD_Q(u + 1);
#pragma unroll
        for (int qt = 0; qt < 2; ++qt)
#pragma unroll
            for (int t = 0; t < 9; ++t)
#pragma unroll
                for (int i = 0; i < 4; ++i) s[qt][t][i] = s[qt][t][i] + slope2 * nb[t][i];
        if (n0_ == 0 || n0_ + 320 > Ls_) {
#pragma unroll
            for (int qt = 0; qt < 2; ++qt) { const int qn = n0_ + 32 * wave + 16 * qt + fr;
#pragma unroll
                for (int t = 0; t < 9; ++t)
#pragma unroll
                    for (int i = 0; i < 4; ++i) { const int j = 16 * t + i + jbase; if ((unsigned)(qn + j) >= (unsigned)Ls_) s[qt][t][i] = -1e30f; } }
        }
        float mx[2], lsum[2];
#pragma unroll
        for (int qt = 0; qt < 2; ++qt) { float m = -1e30f;
#pragma unroll
            for (int t = 0; t < 9; ++t) { asm("v_max3_f32 %0, %0, %1, %2" : "+v"(m) : "v"(s[qt][t][0]), "v"(s[qt][t][1])); asm("v_max3_f32 %0, %0, %1, %2" : "+v"(m) : "v"(s[qt][t][2]), "v"(s[qt][t][3])); }
            { const float m1 = __shfl_xor(m, 16); asm("v_max_f32 %0, %0, %1" : "+v"(m) : "v"(m1)); const float m2 = __shfl_xor(m, 32); asm("v_max_f32 %0, %0, %1" : "+v"(m) : "v"(m2)); } mx[qt] = m;
#pragma unroll
            for (int t = 0; t < 9; ++t)
#pragma unroll
                for (int i = 0; i < 4; ++i) s[qt][t][i] = __builtin_amdgcn_exp2f(s[qt][t][i] - m); }
        f32x4 o[2][4], osum[2];
        const bf16x8 ones = __builtin_bit_cast(bf16x8, (u32x4){0x3f803f80u, 0x3f803f80u, 0x3f803f80u, 0x3f803f80u});
#pragma unroll
        for (int qt = 0; qt < 2; ++qt) { osum[qt] = (f32x4){0.f, 0.f, 0.f, 0.f};
#pragma unroll
            for (int dt = 0; dt < 4; ++dt) o[qt][dt] = (f32x4){0.f, 0.f, 0.f, 0.f}; }
#pragma unroll
        for (int kk = 0; kk < 5; ++kk) {
            bf16x8 pop[2];
#pragma unroll
            for (int qt = 0; qt < 2; ++qt) { const int ta = 2 * kk - qt, tb = 2 * kk + 1 - qt; u32x4 pw = (u32x4){0u, 0u, 0u, 0u};
                if (ta >= 0 && ta < 9) { pw.x = cvtpk(s[qt][ta][0], s[qt][ta][1]); pw.y = cvtpk(s[qt][ta][2], s[qt][ta][3]); }
                if (tb >= 0 && tb < 9) { pw.z = cvtpk(s[qt][tb][0], s[qt][tb][1]); pw.w = cvtpk(s[qt][tb][2], s[qt][tb][3]); }
                pop[qt] = __builtin_bit_cast(bf16x8, pw); osum[qt] = __builtin_amdgcn_mfma_f32_16x16x32_bf16(ones, pop[qt], osum[qt], 0, 0, 0); }
#pragma unroll
            for (int dt = 0; dt < 4; ++dt) { const LAS unsigned char* vp = vrow + 8 * dt;
                const bf16x8 va = cat8(tr_read(vp + (32 * kk) * 128), tr_read(vp + (32 * kk + 16) * 128));
#pragma unroll
                for (int qt = 0; qt < 2; ++qt) o[qt][dt] = __builtin_amdgcn_mfma_f32_16x16x32_bf16(va, pop[qt], o[qt][dt], 0, 0, 0); }
        }
#pragma unroll
        for (int qt = 0; qt < 2; ++qt) {
            const int qn = n0_ + 32 * wave + 16 * qt + fr; const size_t tokq = (size_t)b_ * SEQ + (size_t)qn * d_ + r_;
            lsum[qt] = osum[qt][0];
            const float inv = __builtin_amdgcn_rcpf(lsum[qt]);
            u32x4 lo, hi;
            lo.x = cvtpk(o[qt][0][0] * inv, o[qt][0][1] * inv); lo.y = cvtpk(o[qt][0][2] * inv, o[qt][0][3] * inv); lo.z = cvtpk(o[qt][1][0] * inv, o[qt][1][1] * inv); lo.w = cvtpk(o[qt][1][2] * inv, o[qt][1][3] * inv);
            hi.x = cvtpk(o[qt][2][0] * inv, o[qt][2][1] * inv); hi.y = cvtpk(o[qt][2][2] * inv, o[qt][2][3] * inv); hi.z = cvtpk(o[qt][3][0] * inv, o[qt][3][1] * inv); hi.w = cvtpk(o[qt][3][2] * inv, o[qt][3][3] * inv);
            const bool odd = (fr & 1) != 0;
            const u32x4 snd = odd ? lo : hi; u32x4 rcv;
            rcv.x = (unsigned)__builtin_amdgcn_mov_dpp((int)snd.x, 0xB1, 0xf, 0xf, true); rcv.y = (unsigned)__builtin_amdgcn_mov_dpp((int)snd.y, 0xB1, 0xf, 0xf, true);
            rcv.z = (unsigned)__builtin_amdgcn_mov_dpp((int)snd.z, 0xB1, 0xf, 0xf, true); rcv.w = (unsigned)__builtin_amdgcn_mov_dpp((int)snd.w, 0xB1, 0xf, 0xf, true);
            bf16_t* ope = F.OPART + ((size_t)g_ * TT + (tokq - (size_t)(odd ? d_ : 0))) * DM + h_ * 64 + 16 * fq + (odd ? 8 : 0);
            *(u32x4*)ope = odd ? rcv : lo;
            *(u32x4*)(ope + (size_t)d_ * DM) = odd ? hi : rcv;
            if (fq == 0) F.LSE[((size_t)g_ * TT + tokq) * 16 + h_] = mx[qt] + __builtin_amdgcn_logf(lsum[qt]);
        }
    }
#undef ATT_LOAD_KV
#undef ATT_LOAD_Q
#undef ATT_DECODE
}
__device__ __forceinline__ void p4_attn_merge(const Ctx& F) {
    const int gw = F.bid * NWAVES + F.wave, NGW = F.G * NWAVES, lane = lane_id_fresh(), hd = lane >> 2;
#pragma unroll 2
    for (int t = gw; t < TT; t += NGW) {
        const float l0 = F.LSE[(size_t)t * 16 + hd], l1 = F.LSE[((size_t)TT + t) * 16 + hd], l2 = F.LSE[((size_t)2 * TT + t) * 16 + hd];
        const float m = fmaxf(l0, fmaxf(l1, l2)), e0 = exp2f(l0 - m), e1 = exp2f(l1 - m), e2 = exp2f(l2 - m), inv = 1.f / (e0 + e1 + e2);
        const float w[3] = {e0 * inv, e1 * inv, e2 * inv};
        float acc[16];
#pragma unroll
        for (int i = 0; i < 16; ++i) acc[i] = 0.f;
#pragma unroll
        for (int g = 0; g < 3; ++g) { const bf16_t* src = F.OPART + ((size_t)g * TT + t) * DM + 16 * lane;
#pragma unroll
            for (int hv = 0; hv < 2; ++hv) { const u32x4 v = *(const u32x4*)(src + 8 * hv);
                acc[8 * hv + 0] += w[g] * __uint_as_float(v.x << 16); acc[8 * hv + 1] += w[g] * __uint_as_float(v.x & 0xffff0000u); acc[8 * hv + 2] += w[g] * __uint_as_float(v.y << 16); acc[8 * hv + 3] += w[g] * __uint_as_float(v.y & 0xffff0000u);
                acc[8 * hv + 4] += w[g] * __uint_as_float(v.z << 16); acc[8 * hv + 5] += w[g] * __uint_as_float(v.z & 0xffff0000u); acc[8 * hv + 6] += w[g] * __uint_as_float(v.w << 16); acc[8 * hv + 7] += w[g] * __uint_as_float(v.w & 0xffff0000u); } }
#pragma unroll
        for (int hv = 0; hv < 2; ++hv) { u32x4 o; o.x = cvtpk(acc[8 * hv], acc[8 * hv + 1]); o.y = cvtpk(acc[8 * hv + 2], acc[8 * hv + 3]); o.z = cvtpk(acc[8 * hv + 4], acc[8 * hv + 5]); o.w = cvtpk(acc[8 * hv + 6], acc[8 * hv + 7]);
            *(u32x4*)(F.MIXIN + (size_t)t * 2048 + 1024 + 16 * lane + 8 * hv) = o; }
    }
}
__device__ __forceinline__ void p3_conv(const Ctx& F) {
    const int tid = F.wave * 64 + lane_id_fresh();
    if (tid >= 384) return;
    const int cg = tid % 192, half = tid / 192, c0 = cg * 8;
    float w[5][8], bias[8];
#pragma unroll
    for (int i = 0; i < 5; ++i) { const f32x4 a = *(const f32x4*)(F.conv_w + i * XBCW + c0), b = *(const f32x4*)(F.conv_w + i * XBCW + c0 + 4);
        w[i][0] = a.x; w[i][1] = a.y; w[i][2] = a.z; w[i][3] = a.w; w[i][4] = b.x; w[i][5] = b.y; w[i][6] = b.z; w[i][7] = b.w; }
    { const f32x4 a = *(const f32x4*)(F.conv_b + c0), b = *(const f32x4*)(F.conv_b + c0 + 4); bias[0] = a.x; bias[1] = a.y; bias[2] = a.z; bias[3] = a.w; bias[4] = b.x; bias[5] = b.y; bias[6] = b.z; bias[7] = b.w; }
    for (int u = F.bid; u < TT / 64; u += F.G) {
        const int tbase = u * 64 + half * 32, pos0 = tbase % SEQ;
        const bf16_t* src = F.PROJ + (size_t)tbase * NPROJ + C_XBC + c0;
        u32x4 rows[36];
#pragma unroll
        for (int i = 0; i < 36; ++i) { const int p = pos0 + i - 2; rows[i] = (p >= 0 && p < SEQ) ? __builtin_nontemporal_load((const u32x4*)(src + (ptrdiff_t)(i - 2) * NPROJ)) : (u32x4){0u, 0u, 0u, 0u}; }
#pragma unroll
        for (int t = 0; t < 32; ++t) {
            float acc[8];
#pragma unroll
            for (int k = 0; k < 8; ++k) acc[k] = bias[k];
#pragma unroll
            for (int i = 0; i < 5; ++i) { const u32x4 v = rows[t + i];
                acc[0] += __uint_as_float(v.x << 16) * w[i][0]; acc[1] += __uint_as_float(v.x & 0xffff0000u) * w[i][1]; acc[2] += __uint_as_float(v.y << 16) * w[i][2]; acc[3] += __uint_as_float(v.y & 0xffff0000u) * w[i][3];
                acc[4] += __uint_as_float(v.z << 16) * w[i][4]; acc[5] += __uint_as_float(v.z & 0xffff0000u) * w[i][5]; acc[6] += __uint_as_float(v.w << 16) * w[i][6]; acc[7] += __uint_as_float(v.w & 0xffff0000u) * w[i][7]; }
            u32x4 o; o.x = pk2(siluf(acc[0]), siluf(acc[1])); o.y = pk2(siluf(acc[2]), siluf(acc[3])); o.z = pk2(siluf(acc[4]), siluf(acc[5])); o.w = pk2(siluf(acc[6]), siluf(acc[7]));
            *(u32x4*)(F.XC + (size_t)(tbase + t) * XBCW + c0) = o;
        }
    }
}
__device__ __forceinline__ int ximg_off(int s, int p) { return s * 128 + ((((p >> 4) ^ ((s >> 1) & 3))) << 5) + (p & 15) * 2; }

__device__ __forceinline__ void p4_states(const Ctx& F) {
    const int lane = lane_id_fresh(), wave = F.wave, tid = wave * 64 + lane, fr = lane & 15, fq = lane >> 4;
    LAS unsigned char* BIMG = F.lds;
    LAS unsigned char* XIMG = F.lds + 32768;
    LAS float* WTAB = (LAS float*)(F.lds + 98304);
    for (int u = F.bid; u < 256; u += F.G) {
        const int g = u & 1, c = (u >> 1) & 63, b = u >> 7; const size_t t0 = (size_t)b * SEQ + c * 128;
        const int b_rsub = tid >> 4, b_c16 = tid & 15, x_rsub = tid >> 5, x_c32 = tid & 31;
        const bf16_t* bgp = F.XC + (t0 + b_rsub) * XBCW + 1024 + g * 128 + b_c16 * 8;
        const bf16_t* xgp = F.XC + (t0 + x_rsub) * XBCW + (g * 8) * 64 + x_c32 * 8;
        LAS unsigned char* blp = BIMG + b_rsub * 256 + (((b_c16 >> 1) ^ (b_rsub & 7)) << 5) + (b_c16 & 1) * 16;
        LAS unsigned char* xlp = XIMG + (x_c32 >> 3) * 16384 + x_rsub * 128 + ((((x_c32 & 7) >> 1) ^ ((x_rsub >> 1) & 3)) << 5) + (x_c32 & 1) * 16;
        u32x4 bi[4], xi[8];
#pragma unroll
        for (int i = 0; i < 4; ++i) bi[i] = *(const u32x4*)(bgp + (size_t)i * 32 * XBCW);
#pragma unroll
        for (int i = 0; i < 8; ++i) xi[i] = *(const u32x4*)(xgp + (size_t)i * 16 * XBCW);
        {
            const int hd = g * 8 + wave;
            float a2v[2], d0v[2], d1v[2];
#pragma unroll
            for (int dir = 0; dir < 2; ++dir) { a2v[dir] = F.a_log[dir * 16 + hd]; d0v[dir] = F.DT[((t0 >> 7) * 32 + dir * 16 + hd) * 128 + lane]; d1v[dir] = F.DT[((t0 >> 7) * 32 + dir * 16 + hd) * 128 + 64 + lane]; }
#pragma unroll
            for (int dir = 0; dir < 2; ++dir) {
                const float a2 = -__expf(a2v[dir]) * LOG2E;
                const float d0 = d0v[dir], d1 = d1v[dir];
                float p0 = a2 * d0, p1 = a2 * d1;
#pragma unroll
                for (int o = 1; o < 64; o <<= 1) { const float q0 = __shfl_up(p0, o), q1 = __shfl_up(p1, o); if (lane >= o) { p0 += q0; p1 += q1; } }
                const float tot0 = __shfl(p0, 63), tot1 = __shfl(p1, 63), tot = tot0 + tot1;
                float c0, c1, w0, w1;
                if (dir == 0) { c0 = p0; c1 = tot0 + p1; w0 = exp2f(tot - c0) * d0; w1 = exp2f(tot - c1) * d1; }
                else { c0 = tot - (p0 - a2 * d0); c1 = tot - (tot0 + p1 - a2 * d1); w0 = exp2f(tot - c0) * d0; w1 = exp2f(tot - c1) * d1; }
                F.CUM[((t0 >> 7) * 32 + dir * 16 + hd) * 128 + lane] = c0; F.CUM[((t0 >> 7) * 32 + dir * 16 + hd) * 128 + 64 + lane] = c1;
                WTAB[(dir * 8 + wave) * 128 + lane] = w0; WTAB[(dir * 8 + wave) * 128 + 64 + lane] = w1;
                if (lane == 0) F.CHDEC[((b * 2 + dir) * 64 + c) * 16 + hd] = exp2f(tot);
            }
        }
#pragma unroll
        for (int i = 0; i < 4; ++i) *(LAS u32x4*)(blp + i * 32 * 256) = bi[i];
#pragma unroll
        for (int i = 0; i < 8; ++i) *(LAS u32x4*)(xlp + i * 16 * 128) = xi[i];
        __syncthreads();
#pragma unroll
        for (int i = 0; i < 8; ++i) xi[i] = *(const u32x4*)(xgp + 4 * 64 + (size_t)i * 16 * XBCW);
        auto quad = [&](const int hq) __attribute__((always_inline)) {
            const int q = wave >> 1, dir = wave & 1, hd = g * 8 + hq * 4 + q;
            const LAS float* wt = WTAB + (dir * 8 + hq * 4 + q) * 128 + 4 * fq;
            const int rq = (lane & 15) >> 2, cq = lane & 3, rl = 4 * fq + rq;
            const LAS unsigned char* xrow = XIMG + q * 16384 + rl * 128 + cq * 8;
            const LAS unsigned char* brow = BIMG + rl * 256;
            const int xsw = (rl >> 1) & 3, bsw = rl & 7;
            bf16_t* So = F.STATES + ((size_t)((b * 2 + dir) * 64 + c) * 16 + hd) * 8192;
#pragma unroll 1
            for (int nh = 0; nh < 2; ++nh) {
                f32x4 acc[4][4];
#pragma unroll
                for (int nt = 0; nt < 4; ++nt)
#pragma unroll
                    for (int pt = 0; pt < 4; ++pt) acc[nt][pt] = (f32x4){0.f, 0.f, 0.f, 0.f};
#pragma unroll
                for (int ks = 0; ks < 4; ++ks) {
                    const f32x4 w1 = *(const LAS f32x4*)(wt + 32 * ks), w2 = *(const LAS f32x4*)(wt + 32 * ks + 16);
                    bf16x8 xb[4];
#pragma unroll
                    for (int pt = 0; pt < 4; ++pt) {
                        const LAS unsigned char* xp = xrow + ((pt ^ xsw) << 5);
                        const s16x4 a = tr_read(xp + (32 * ks) * 128), bq = tr_read(xp + (32 * ks + 16) * 128);
                        u32x4 o;
                        o.x = cvtpk(bf2f((bf16_t)a[0]) * w1[0], bf2f((bf16_t)a[1]) * w1[1]); o.y = cvtpk(bf2f((bf16_t)a[2]) * w1[2], bf2f((bf16_t)a[3]) * w1[3]);
                        o.z = cvtpk(bf2f((bf16_t)bq[0]) * w2[0], bf2f((bf16_t)bq[1]) * w2[1]); o.w = cvtpk(bf2f((bf16_t)bq[2]) * w2[2], bf2f((bf16_t)bq[3]) * w2[3]);
                        xb[pt] = __builtin_bit_cast(bf16x8, o);
                    }
#pragma unroll
                    for (int nt = 0; nt < 4; ++nt) {
                        const LAS unsigned char* bp = brow + (((nh * 4 + cq) ^ bsw) << 5) + 8 * nt;
                        const bf16x8 bt = cat8(tr_read(bp + (32 * ks) * 256), tr_read(bp + (32 * ks + 16) * 256));
#pragma unroll
                        for (int pt = 0; pt < 4; ++pt) acc[nt][pt] = __builtin_amdgcn_mfma_f32_16x16x32_bf16(bt, xb[pt], acc[nt][pt], 0, 0, 0);
                    }
                }
                const bool odd = (fr & 1) != 0;
#pragma unroll
                for (int pt = 0; pt < 4; ++pt) { u32x4 lo, hi;
                    lo.x = cvtpk(acc[0][pt][0], acc[0][pt][1]); lo.y = cvtpk(acc[0][pt][2], acc[0][pt][3]); lo.z = cvtpk(acc[1][pt][0], acc[1][pt][1]); lo.w = cvtpk(acc[1][pt][2], acc[1][pt][3]);
                    hi.x = cvtpk(acc[2][pt][0], acc[2][pt][1]); hi.y = cvtpk(acc[2][pt][2], acc[2][pt][3]); hi.z = cvtpk(acc[3][pt][0], acc[3][pt][1]); hi.w = cvtpk(acc[3][pt][2], acc[3][pt][3]);
                    const u32x4 snd = odd ? lo : hi; u32x4 rcv;
                    rcv.x = (unsigned)__builtin_amdgcn_mov_dpp((int)snd.x, 0xB1, 0xf, 0xf, true); rcv.y = (unsigned)__builtin_amdgcn_mov_dpp((int)snd.y, 0xB1, 0xf, 0xf, true);
                    rcv.z = (unsigned)__builtin_amdgcn_mov_dpp((int)snd.z, 0xB1, 0xf, 0xf, true); rcv.w = (unsigned)__builtin_amdgcn_mov_dpp((int)snd.w, 0xB1, 0xf, 0xf, true);
                    bf16_t* pe = So + (16 * pt + (fr & ~1)) * 128 + 64 * nh + 16 * fq + (odd ? 8 : 0);
                    *(u32x4*)pe = odd ? rcv : lo; *(u32x4*)(pe + 128) = odd ? hi : rcv; }
            }
        };
        quad(0);
        __syncthreads();
#pragma unroll
        for (int i = 0; i < 8; ++i) *(LAS u32x4*)(xlp + i * 16 * 128) = xi[i];
        __syncthreads();
        quad(1);
        __syncthreads();
    }
}

__device__ __forceinline__ void p5_scan(const Ctx& F) {
    const int NTH = F.G * NTHREADS, f_tid = F.wave * 64 + lane_id_fresh();
    for (int gid = F.bid * NTHREADS + f_tid; gid < 2 * 2 * 16 * 64 * 32; gid += NTH) {
        const int n4 = gid & 31, p = (gid >> 5) & 63, hd = (gid >> 11) & 15, dir = (gid >> 15) & 1, b = gid >> 16;
        const size_t eoff = ((size_t)((b * 2 + dir) * 64) * 16 + hd) * 8192 + p * 128 + n4 * 4;
        const bf16_t* base = F.STATES + eoff; bf16_t* obase = F.HPREV + eoff;
        const float* dec = F.CHDEC + ((b * 2 + dir) * 64) * 16 + hd;
        float h0 = 0.f, h1 = 0.f, h2 = 0.f, h3 = 0.f;
#pragma unroll 8
        for (int i = 0; i < 64; ++i) {
            const int c = dir ? 63 - i : i;
            const u32x2 s = __builtin_nontemporal_load((const u32x2*)(base + (size_t)c * 16 * 8192)); const float d = dec[c * 16];
            u32x2 o; o.x = pk2(h0, h1); o.y = pk2(h2, h3); *(u32x2*)(obase + (size_t)c * 16 * 8192) = o;
            h0 = h0 * d + __uint_as_float(s.x << 16); h1 = h1 * d + __uint_as_float(s.x & 0xffff0000u); h2 = h2 * d + __uint_as_float(s.y << 16); h3 = h3 * d + __uint_as_float(s.y & 0xffff0000u);
        }
    }
}

__device__ __forceinline__ void p6_ssd_out(const Ctx& F) {
    const int lane = lane_id_fresh(), wave = F.wave, fr = lane & 15, fq = lane >> 4;
    LAS unsigned char* BIMG = F.lds;
    LAS unsigned char* XIMG = F.lds + 32768;
    LAS unsigned char* HST = F.lds + 65536;
    LAS float* TABS = (LAS float*)(F.lds + LDSCTL_OFF + 2048);
    LAS float* GSS = (LAS float*)(F.lds + LDSCTL_OFF + 10240);
#pragma unroll 1
    for (int u = F.bid; u < 256; u += F.G) {
        const int tid = wave * 64 + lane_id_fresh();
        const int g = u & 1, c = (u >> 1) & 63, b = u >> 7; const size_t t0 = (size_t)b * SEQ + c * 128;
        const int lrow = 16 * wave + fr;
        __syncthreads();
        if (tid < 256) *(LAS f32x4*)(GSS + 4 * tid) = *(const f32x4*)(F.g_ssd + 4 * tid); else if (tid < 272) GSS[1024 + tid - 256] = F.d_skip[tid - 256];
        { const int i_rsub = tid >> 5, i_c32 = tid & 31, i_row = 2 * i_rsub + (i_c32 >> 4), i_c16 = i_c32 & 15;
            const bf16_t* gp = F.XC + (t0 + i_row) * XBCW + 1024 + g * 128 + i_c16 * 8;
            LAS unsigned char* lp = BIMG + i_row * 256 + ((i_c16 ^ (i_row & 15)) << 4);
            u32x4 bi[4];
#pragma unroll
            for (int i = 0; i < 4; ++i) bi[i] = __builtin_nontemporal_load((const u32x4*)(gp + (size_t)i * 32 * XBCW));
            asm volatile("" : "+v"(bi[0]), "+v"(bi[1]), "+v"(bi[2]), "+v"(bi[3]));
#pragma unroll
            for (int i = 0; i < 4; ++i) *(LAS u32x4*)(lp + i * 32 * 256) = bi[i]; }
        u32x4 xr[2]; float tr0;
        const int x_rsub = tid >> 3, x_c8 = tid & 7;
        const bf16_t* xg = F.XC + (t0 + x_rsub) * XBCW + (g * 8) * 64 + x_c8 * 8;
        LAS unsigned char* xl = XIMG + x_rsub * 128 + (((x_c8 >> 1) ^ ((x_rsub >> 1) & 3)) << 5) + (x_c8 & 1) * 16;
        const int t_arr = tid >> 7, t_l = tid & 127;
        const float* tg = ((t_arr >> 1) ? F.DT : F.CUM) + ((t0 >> 7) * 32 + (t_arr & 1) * 16 + g * 8) * 128 + t_l;
        LAS float* tl = TABS + t_arr * 128 + t_l;
#define LOAD_X(step) do { _Pragma("unroll") for (int i = 0; i < 2; ++i) xr[i] = __builtin_nontemporal_load((const u32x4*)(xg + (step) * 64 + (size_t)i * 64 * XBCW)); tr0 = tg[(step) * 128]; } while (0)
#define STORE_X(buf) do { _Pragma("unroll") for (int i = 0; i < 2; ++i) *(LAS u32x4*)(xl + (buf) * 16384 + i * 64 * 128) = xr[i]; tl[(buf) * 512] = tr0; } while (0)
        int hoff[4];
#pragma unroll
        for (int k = 0; k < 4; ++k) hoff[k] = (lane >> 4) * 128 + (((lane & 15) ^ (4 * k + (lane >> 4))) << 3);
#define H_DMA(step, buf) do { _Pragma("unroll") for (int j = 0; j < 4; ++j) { const int P = wave * 4 + j, dir = P >> 4, pp = P & 15; \
            const bf16_t* hb = F.HPREV + ((size_t)((b * 2 + dir) * 64 + c) * 16 + g * 8 + (step)) * 8192 + pp * 512; \
            __builtin_amdgcn_global_load_lds((const unsigned*)(hb + hoff[j]), (LAS unsigned*)(HST + (buf) * 32768 + dir * 16384 + pp * 1024), 16, 0, 2  ); } } while (0)
        LOAD_X(0);
        H_DMA(0, 0);
        float ssq = 0.f;
        u32x2 zvn[4];
        const int rq = (lane & 15) >> 2, cq = lane & 3, rl = 4 * fq + rq, xsw = (rl >> 1) & 3;
        const int xself = lrow * 128 + 8 * fq, xselfsw = (lrow >> 1) & 3;
        const size_t tok = t0 + lrow;
        const int ldiff = lrow - 4 * fq;
        const bf16_t* zg = F.PROJ + tok * NPROJ + C_Z + (g * 8) * 64 + 4 * fq;
#pragma unroll
        for (int pt = 0; pt < 4; ++pt) zvn[pt] = *(const u32x2*)(zg + 16 * pt);
        bf16x8 cfr[4]; f32x4 G[8];
#pragma unroll
        for (int ks = 0; ks < 4; ++ks) cfr[ks] = *(const bf16x8*)(F.XC + tok * XBCW + 1280 + g * 128 + 32 * ks + 8 * fq);
        __syncthreads();
#pragma unroll
        for (int st = 0; st < 8; ++st) { f32x4 a = (f32x4){0.f, 0.f, 0.f, 0.f}; const int s = 16 * st + fr;
#pragma unroll
            for (int ks = 0; ks < 4; ++ks) { const bf16x8 bfrag = *(const LAS bf16x8*)(BIMG + s * 256 + (((4 * ks + fq) ^ fr) << 4));
                a = __builtin_amdgcn_mfma_f32_16x16x32_bf16(bfrag, cfr[ks], a, 0, 0, 0); }
            G[st] = a; }
        STORE_X(0);
#pragma unroll 1
        for (int step = 0; step < 8; ++step) {
            const int hd = g * 8 + step, buf = step & 1;
            if (step == 0) asm volatile("s_waitcnt vmcnt(0)" ::: "memory"); else asm volatile("s_waitcnt vmcnt(4)" ::: "memory");
            __syncthreads();
            u32x2 zv[4];
#pragma unroll
            for (int pt = 0; pt < 4; ++pt) zv[pt] = zvn[pt];
            if (step < 7) { H_DMA(step + 1, buf ^ 1); LOAD_X(step + 1);
#pragma unroll
                for (int pt = 0; pt < 4; ++pt) zvn[pt] = *(const u32x2*)(zg + (step + 1) * 64 + 16 * pt); }
            const LAS unsigned char* xi = XIMG + buf * 16384;
            const LAS unsigned char* xrow = xi + rl * 128 + cq * 8;
            const LAS float* tb = TABS + buf * 512;
            const float cfl = tb[lrow], cbl = tb[128 + lrow];
            f32x4 acc[4];
#pragma unroll
            for (int pt = 0; pt < 4; ++pt) acc[pt] = (f32x4){0.f, 0.f, 0.f, 0.f};
#pragma unroll
            for (int dir = 0; dir < 2; ++dir) {
                f32x4 aco[4];
#pragma unroll
                for (int pt = 0; pt < 4; ++pt) aco[pt] = (f32x4){0.f, 0.f, 0.f, 0.f};
                const LAS unsigned char* hs = HST + buf * 32768 + dir * 16384 + fr * 256;
#pragma unroll
                for (int ks = 0; ks < 4; ++ks) {
                    u32x4 hf_[4];
                    const unsigned ha = (unsigned)(unsigned long long)(hs + (((4 * ks + fq) ^ fr) << 4));
                    hf_[0] = lds_read_a<0>(ha); hf_[1] = lds_read_a<4096>(ha); hf_[2] = lds_read_a<8192>(ha); hf_[3] = lds_read_a<12288>(ha);
                    lds_wait4(hf_);
#pragma unroll
                    for (int pt = 0; pt < 4; ++pt) aco[pt] = __builtin_amdgcn_mfma_f32_16x16x32_bf16(__builtin_bit_cast(bf16x8, hf_[pt]), cfr[ks], aco[pt], 0, 0, 0);
                }
                const float el = __builtin_amdgcn_exp2f(dir ? cbl : cfl);
#pragma unroll
                for (int pt = 0; pt < 4; ++pt) acc[pt] = acc[pt] + aco[pt] * el;
            }
            bf16x8 mop[4];
#pragma unroll
            for (int ks = 0; ks < 4; ++ks) {
                unsigned pk[4];
#pragma unroll
                for (int hf = 0; hf < 2; ++hf) {
                    const int st = 2 * ks + hf;
                    const LAS float* ts = tb + 4 * fq + 16 * st;
                    const f32x4 cfs = *(const LAS f32x4*)(ts), cbs = *(const LAS f32x4*)(ts + 128), dfs = *(const LAS f32x4*)(ts + 256), dbs = *(const LAS f32x4*)(ts + 384);
                    float mv[4];
#pragma unroll
                    for (int i = 0; i < 4; ++i) { const bool fw = (16 * st + i) <= ldiff;
                        const float ar = fw ? cfl - cfs[i] : cbl - cbs[i], wg = fw ? dfs[i] : dbs[i];
                        float v = __builtin_amdgcn_exp2f(ar) * wg; if ((16 * st + i) == ldiff) v += dbs[i];
                        mv[i] = v * G[st][i]; }
                    pk[2 * hf] = cvtpk(mv[0], mv[1]); pk[2 * hf + 1] = cvtpk(mv[2], mv[3]);
                }
                mop[ks] = __builtin_bit_cast(bf16x8, (u32x4){pk[0], pk[1], pk[2], pk[3]});
            }
#pragma unroll
            for (int pt = 0; pt < 4; ++pt) { const unsigned xp = (unsigned)(unsigned long long)(xrow + ((pt ^ xsw) << 5));
                u32x2 t[8];
                t[0] = tr_read_a<0>(xp); t[1] = tr_read_a<2048>(xp); t[2] = tr_read_a<4096>(xp); t[3] = tr_read_a<6144>(xp);
                t[4] = tr_read_a<8192>(xp); t[5] = tr_read_a<10240>(xp); t[6] = tr_read_a<12288>(xp); t[7] = tr_read_a<14336>(xp);
                tr_wait8(t);
#pragma unroll
                for (int ks = 0; ks < 4; ++ks) { const bf16x8 xa = __builtin_bit_cast(bf16x8, (u32x4){t[2 * ks].x, t[2 * ks].y, t[2 * ks + 1].x, t[2 * ks + 1].y});
                    acc[pt] = __builtin_amdgcn_mfma_f32_16x16x32_bf16(xa, mop[ks], acc[pt], 0, 0, 0); } }
            if (step < 7) { asm volatile("s_waitcnt vmcnt(0)" ::: "memory");
                STORE_X(buf ^ 1); asm volatile("" : "+v"(zvn[0]), "+v"(zvn[1]), "+v"(zvn[2]), "+v"(zvn[3])); }
            const float dsk = GSS[1024 + hd];
#pragma unroll
            for (int pt = 0; pt < 4; ++pt) {
                const int p0 = 16 * pt + 4 * fq;
                const u32x2 xv = *(const LAS u32x2*)(xi + xself + ((pt ^ xselfsw) << 5));
                const f32x4 gs = *(const LAS f32x4*)(GSS + hd * 64 + p0);
                const float xf[4] = {__uint_as_float(xv.x << 16), __uint_as_float(xv.x & 0xffff0000u), __uint_as_float(xv.y << 16), __uint_as_float(xv.y & 0xffff0000u)};
                const float zf[4] = {__uint_as_float(zv[pt].x << 16), __uint_as_float(zv[pt].x & 0xffff0000u), __uint_as_float(zv[pt].y << 16), __uint_as_float(zv[pt].y & 0xffff0000u)};
                float o[4];
#pragma unroll
                for (int i = 0; i < 4; ++i) { const float y = (acc[pt][i] + dsk * xf[i]) * siluf(zf[i]); ssq += y * y; o[i] = y * gs[i]; }
                u32x2 w; w.x = cvtpk(o[0], o[1]); w.y = cvtpk(o[2], o[3]);
                *(u32x2*)(F.MIXIN + tok * 2048 + hd * 64 + p0) = w;
            }
        }
#undef LOAD_X
#undef STORE_X
#undef H_DMA
        ssq += __shfl_xor(ssq, 16); ssq += __shfl_xor(ssq, 32);
        if (fq == 0) F.RR[(size_t)g * TT + tok] = ssq;
    }
}
__device__ __forceinline__ void p7_postmix(const Ctx& F) {
    const int lane = lane_id_fresh(), wave = F.wave, tid = wave * 64 + lane, fr = lane & 15, fq = lane >> 4;
    LAS unsigned char* HL = F.lds;
    LAS float* PART = (LAS float*)(F.lds + 65536);
    LAS int* SEL = (LAS int*)(F.lds + 81920);
    LAS float* SELW = (LAS float*)(F.lds + 82944);
    LAS int* HIST = (LAS int*)(F.lds + 83968);
    LAS float* CST = (LAS float*)(F.lds + 86016);
    unsigned* ecount = F.ctl + CW_ECOUNT;
    bf16x8 wh[2][4], wl[2][4];
#pragma unroll
    for (int et = 0; et < 2; ++et)
#pragma unroll
        for (int ks = 0; ks < 4; ++ks) { const bf16_t* p = F.WRT + (16 * et + fr) * DM + 128 * wave + 32 * ks + 8 * fq; wh[et][ks] = *(const bf16x8*)p; wl[et][ks] = *(const bf16x8*)(p + NEXP * DM); }
    for (int blk = F.bid; blk < TT / 64; blk += F.G) {
        if (tid < 32) HIST[tid] = 0;
        { const float* mb = F.mod + ((blk * 64) / SEQ) * 6144;
            for (int i = tid; i < 1280; i += NTHREADS) { const int a = i >> 8, c4 = (i & 255) * 4;
                const float* sp = a == 0 ? mb + 2048 : a == 1 ? F.g_post_mix : a == 2 ? F.g_pre_ffn : a == 3 ? mb + 4096 : mb + 3072;
                *(LAS f32x4*)(CST + a * 1024 + c4) = *(const f32x4*)(sp + c4); } }
        u32x2 qn[4]; f32x4 xn[4];
#define PM_LOAD(idx) do { const size_t t_ = (size_t)(blk * 64 + ((idx) >> 1) * 16 + 2 * wave + ((idx) & 1)) * DM + 4 * lane; _Pragma("unroll") for (int j = 0; j < 4; ++j) { \
            qn[j] = __builtin_nontemporal_load((const u32x2*)(F.MIX + t_ + 256 * j)); xn[j] = __builtin_nontemporal_load((const f32x4*)(F.x + t_ + 256 * j)); } } while (0)
        PM_LOAD(0);
        __syncthreads();
#pragma unroll
        for (int grp = 0; grp < 4; ++grp) {
#pragma unroll
            for (int rr = 0; rr < 2; ++rr) {
                const int row = 2 * wave + rr, t = blk * 64 + grp * 16 + row;
                float mv[16], rv[16]; float ss = 0.f;
                f32x4 xc[4];
#pragma unroll
                for (int j = 0; j < 4; ++j) { const u32x2 q = qn[j]; xc[j] = xn[j];
                    const f32x4 v = (f32x4){__uint_as_float(q.x << 16), __uint_as_float(q.x & 0xffff0000u), __uint_as_float(q.y << 16), __uint_as_float(q.y & 0xffff0000u)};
                    mv[4 * j] = v.x; mv[4 * j + 1] = v.y; mv[4 * j + 2] = v.z; mv[4 * j + 3] = v.w; ss += v.x * v.x + v.y * v.y + v.z * v.z + v.w * v.w; }
                if (grp * 2 + rr < 7) PM_LOAD(grp * 2 + rr + 1);
                const float r = rsqrtf(wave_sum(ss) * (1.f / DM) + RMS_EPS);
                float ss2 = 0.f;
#pragma unroll
                for (int j = 0; j < 4; ++j) { const int c0 = 4 * lane + 256 * j; const f32x4 xv = xc[j], gm = *(const LAS f32x4*)(CST + c0), gp = *(const LAS f32x4*)(CST + 1024 + c0);
#pragma unroll
                    for (int i = 0; i < 4; ++i) { const float v = xv[i] + gm[i] * (mv[4 * j + i] * r * gp[i]); rv[4 * j + i] = v; ss2 += v * v; } }
                const float r2 = rsqrtf(wave_sum(ss2) * (1.f / DM) + RMS_EPS);
#pragma unroll
                for (int j = 0; j < 4; ++j) {
                    const int c0 = 4 * lane + 256 * j; const f32x4 gp = *(const LAS f32x4*)(CST + 2048 + c0), sc = *(const LAS f32x4*)(CST + 3072 + c0), sh = *(const LAS f32x4*)(CST + 4096 + c0);
                    float hv[4];
#pragma unroll
                    for (int i = 0; i < 4; ++i) hv[i] = rv[4 * j + i] * r2 * gp[i] * (1.f + sc[i]) + sh[i];
                    { u32x2 rq; rq.x = cvtpk(rv[4 * j], rv[4 * j + 1]); rq.y = cvtpk(rv[4 * j + 2], rv[4 * j + 3]); *(u32x2*)(F.RES + (size_t)t * DM + c0) = rq; }
                    u32x2 hi; hi.x = cvtpk(hv[0], hv[1]); hi.y = cvtpk(hv[2], hv[3]);
                    *(u32x2*)(F.H + (size_t)t * DM + c0) = hi;
                    u32x2 lo; lo.x = cvtpk(hv[0] - __uint_as_float(hi.x << 16), hv[1] - __uint_as_float(hi.x & 0xffff0000u)); lo.y = cvtpk(hv[2] - __uint_as_float(hi.y << 16), hv[3] - __uint_as_float(hi.y & 0xffff0000u));
                    const int chunk = (lane >> 1) + 32 * j, off = row * 4096 + ((chunk ^ row) << 4) + (lane & 1) * 8;
                    *(LAS u32x2*)(HL + off) = hi; *(LAS u32x2*)(HL + 2048 + off) = lo;
                }
            }
            __syncthreads();
            { f32x4 acc[2] = {(f32x4){0.f, 0.f, 0.f, 0.f}, (f32x4){0.f, 0.f, 0.f, 0.f}};
#pragma unroll
                for (int ks = 0; ks < 4; ++ks) { const int off = fr * 4096 + (((16 * wave + 4 * ks + fq) ^ fr) << 4);
                    const bf16x8 ah = *(const LAS bf16x8*)(HL + off), al = *(const LAS bf16x8*)(HL + 2048 + off);
#pragma unroll
                    for (int et = 0; et < 2; ++et) { acc[et] = __builtin_amdgcn_mfma_f32_16x16x32_bf16(al, wh[et][ks], acc[et], 0, 0, 0); acc[et] = __builtin_amdgcn_mfma_f32_16x16x32_bf16(ah, wl[et][ks], acc[et], 0, 0, 0);
                        acc[et] = __builtin_amdgcn_mfma_f32_16x16x32_bf16(ah, wh[et][ks], acc[et], 0, 0, 0); } }
#pragma unroll
                for (int et = 0; et < 2; ++et)
#pragma unroll
                    for (int i = 0; i < 4; ++i) PART[(wave * 16 + 4 * fq + i) * 32 + 16 * et + fr] = acc[et][i]; }
            __syncthreads();
            { const int e = lane & 31, row = 2 * wave + (lane >> 5);
                float v = F.b_router[e];
#pragma unroll
                for (int w = 0; w < 8; ++w) v += PART[(w * 16 + row) * 32 + e];
                int ti[4]; float tv[4];
#pragma unroll
                for (int k = 0; k < 4; ++k) {
                    float bv = v; int bi = e;
#pragma unroll
                    for (int o = 16; o >= 1; o >>= 1) { const float ov = __shfl_xor(bv, o); const int oi = __shfl_xor(bi, o); if (ov > bv || (ov == bv && oi < bi)) { bv = ov; bi = oi; } }
                    ti[k] = bi; tv[k] = bv; if (e == bi) v = -INFINITY;
                }
                const float e1 = __expf(tv[1] - tv[0]), e2 = __expf(tv[2] - tv[0]), e3 = __expf(tv[3] - tv[0]), inv = 1.f / (1.f + e1 + e2 + e3);
                if (e < 4) { int ex = ti[0]; float w = inv;
                    if (e == 1) { ex = ti[1]; w = e1 * inv; } else if (e == 2) { ex = ti[2]; w = e2 * inv; } else if (e == 3) { ex = ti[3]; w = e3 * inv; }
                    SEL[(grp * 16 + row) * 4 + e] = ex; SELW[(grp * 16 + row) * 4 + e] = w; } }
            __syncthreads();
        }
#undef PM_LOAD
        int myex = 0, myloc = 0;
        if (tid < 256) { myex = SEL[tid]; myloc = __hip_atomic_fetch_add(&HIST[myex], 1, __ATOMIC_RELAXED, __HIP_MEMORY_SCOPE_WORKGROUP); }
        __syncthreads();
        if (tid < 32) { const int c = HIST[tid]; HIST[32 + tid] = c ? (int)atomicAdd(&ecount[tid], (unsigned)c) : 0; }
        __syncthreads();
        if (tid < 256) { const int slot = (blk * 64 + (tid >> 2)) * 4 + (tid & 3); const int pos = myex * TT + HIST[32 + myex] + myloc; F.SORT[pos] = slot; F.SORTW[pos] = SELW[tid]; }
        __syncthreads();
    }
}
__device__ __forceinline__ void p10_final(const Ctx& F) {
    const int gw = F.bid * NWAVES + F.wave, NGW = F.G * NWAVES, lane = lane_id_fresh();
    for (int t0 = gw; t0 < TT; t0 += 2 * NGW) {
        const int tt[2] = {t0, t0 + NGW < TT ? t0 + NGW : t0};
        u32x2 y[2][4][4], rq[2][4]; u32x4 flv[2];
#pragma unroll
        for (int q = 0; q < 2; ++q) flv[q] = *(const u32x4*)(F.FLG + 4 * tt[q]);
#pragma unroll
        for (int q = 0; q < 2; ++q)
#pragma unroll
            for (int j = 0; j < 4; ++j) { const int c0 = 4 * lane + 256 * j;
#pragma unroll
                for (int k = 0; k < 4; ++k) y[q][j][k] = __builtin_nontemporal_load((const u32x2*)(F.YSLOT + (size_t)(tt[q] * 4 + k) * DM + c0));
                rq[q][j] = *(const u32x2*)(F.RES + (size_t)tt[q] * DM + c0); }
        f32x4 gg[2][4];
#pragma unroll
        for (int q = 0; q < 2; ++q) { const float* gate = F.mod + (tt[q] / SEQ) * 6144 + 5120;
#pragma unroll
            for (int j = 0; j < 4; ++j) { const int c0 = 4 * lane + 256 * j; if (q == 0 || tt[1] / SEQ != tt[0] / SEQ) gg[q][j] = *(const f32x4*)(gate + c0) * *(const f32x4*)(F.g_post_ffn + c0); else gg[q][j] = gg[0][j]; } }
#pragma unroll
        for (int q = 0; q < 2; ++q) {
            const int t = tt[q];
            float f[16]; float ss = 0.f;
#pragma unroll
            for (int j = 0; j < 4; ++j) { float s[4] = {0.f, 0.f, 0.f, 0.f};
#pragma unroll
                for (int k = 0; k < 4; ++k) { const u32x2 v = y[q][j][k];
                    s[0] += __uint_as_float(v.x << 16); s[1] += __uint_as_float(v.x & 0xffff0000u); s[2] += __uint_as_float(v.y << 16); s[3] += __uint_as_float(v.y & 0xffff0000u); }
#pragma unroll
                for (int i = 0; i < 4; ++i) f[4 * j + i] = s[i]; }
            if (__builtin_amdgcn_readfirstlane((int)(flv[q].x | flv[q].y | flv[q].z | flv[q].w))) {
#pragma unroll
                for (int k = 0; k < 4; ++k) { const unsigned fk = (unsigned)__builtin_amdgcn_readfirstlane((int)flv[q][k]);
                    for (int pp = 0; pp + 1 < (int)(fk >> 24); ++pp) { const bf16_t* src = F.YSLOT + (size_t)(QBASE_ROWS + pp * QROWS + (int)(fk & 0xffffffu)) * DM + 4 * lane;
#pragma unroll
                        for (int j = 0; j < 4; ++j) { const u32x2 v = *(const u32x2*)(src + 256 * j);
                            f[4 * j] += __uint_as_float(v.x << 16); f[4 * j + 1] += __uint_as_float(v.x & 0xffff0000u); f[4 * j + 2] += __uint_as_float(v.y << 16); f[4 * j + 3] += __uint_as_float(v.y & 0xffff0000u); } } }
            }
#pragma unroll
            for (int i = 0; i < 16; ++i) ss += f[i] * f[i];
            const float r = rsqrtf(wave_sum(ss) * (1.f / DM) + RMS_EPS);
#pragma unroll
            for (int j = 0; j < 4; ++j) { const int c0 = 4 * lane + 256 * j; const f32x4 g4 = gg[q][j]; const u32x2 rr = rq[q][j];
                f32x4 o = (f32x4){__uint_as_float(rr.x << 16), __uint_as_float(rr.x & 0xffff0000u), __uint_as_float(rr.y << 16), __uint_as_float(rr.y & 0xffff0000u)};
#pragma unroll
                for (int i = 0; i < 4; ++i) o[i] += g4[i] * (f[4 * j + i] * r);
                __builtin_nontemporal_store(o, (f32x4*)(F.out + (size_t)t * DM + c0)); }
        }
    }
}

struct Args { const float* in[22]; float* out; unsigned char* ws; int ph_lo, ph_hi; };
__global__ void __launch_bounds__(NTHREADS, 2) mk_fwd(Args args) {
    extern __shared__ __attribute__((aligned(16))) unsigned char lds_raw[];
    Ctx F;
    F.lds = (LAS unsigned char*)lds_raw; F.wave = __builtin_amdgcn_readfirstlane((int)threadIdx.x >> 6); F.G = gridDim.x; F.bid = blockIdx.x;
    unsigned char* ws = args.ws;
    F.x = args.in[0]; F.c = args.in[1]; F.w_ada = args.in[2]; F.b_ada = args.in[3]; F.g_pre_mix = args.in[4]; F.g_post_mix = args.in[5]; F.w_in = args.in[6];
    F.conv_w = args.in[7]; F.conv_b = args.in[8]; F.dt_bias = args.in[9]; F.a_log = args.in[10]; F.d_skip = args.in[11]; F.g_ssd = args.in[12]; F.w_out = args.in[13];
    F.g_pre_ffn = args.in[14]; F.g_post_ffn = args.in[15]; F.w_router = args.in[16]; F.b_router = args.in[17]; F.w_gu = args.in[18]; F.b_gu = args.in[19]; F.w_dn = args.in[20]; F.b_dn = args.in[21];
    F.out = args.out; F.ctl = (unsigned*)(ws + WS_CTL); F.mod = (float*)(ws + WS_MOD); F.FLG = (unsigned*)(ws + WS_FLG); F.QKV = (bf16_t*)(ws + WS_QKV);
    F.WIN = (bf16_t*)(ws + WS_WIN); F.WOUT = (bf16_t*)(ws + WS_WOUT); F.WGU = (bf16_t*)(ws + WS_WGU); F.WDN = (bf16_t*)(ws + WS_WDN);
    F.H = (bf16_t*)(ws + WS_H); F.PROJ = (bf16_t*)(ws + WS_PROJ); F.XC = (bf16_t*)(ws + WS_XC); F.DT = (float*)(ws + WS_DT);
    F.STATES = (bf16_t*)(ws + WS_STATES); F.CUM = (float*)(ws + WS_CUM); F.CHDEC = (float*)(ws + WS_CHDEC); F.OPART = (bf16_t*)(ws + WS_OPART); F.HPREV = (bf16_t*)(ws + WS_HPREV); F.WRT = (bf16_t*)(ws + WS_WRT); F.RES = (bf16_t*)(ws + WS_RES); F.LSE = (float*)(ws + WS_LSE); F.MIXIN = (bf16_t*)(ws + WS_MIXIN); F.MIX = (bf16_t*)(ws + WS_MIX);
    F.TOPW = (float*)(ws + WS_TOPW); F.SORT = (int*)(ws + WS_SORT); F.SORTW = (float*)(ws + WS_SORTW); F.RR = (float*)(ws + WS_RR); F.ACT = (bf16_t*)(ws + WS_ACT); F.YSLOT = (bf16_t*)(ws + WS_YSLOT);
    volatile LAS unsigned* LCTL = (volatile LAS unsigned*)(F.lds + LDSCTL_OFF);
    for (int u = (int)threadIdx.x; u < (LDS_BYTES - LDSCTL_OFF) / 4; u += NTHREADS) LCTL[u] = 0u;
    __syncthreads();
    XcdBarrier bar; bar.bar = F.ctl + CW_BAR; bar.x = 0; bar.st = nullptr;
    if (MK_N_LAUNCHES == 1) bar = xcd_barrier_post(F.ctl + CW_BAR, LCTL);
    const int lo = args.ph_lo, hi = args.ph_hi;
#define IN(k) (lo <= (k) && (k) < hi)
Fill fs; fs.pend = -1; fs.mpend = -1; fs.mopen = 0; fs.wdone = 0; fs.mdone = 0;
#define SEAM(k) do { if (IN(k) && IN((k) + 1)) xcd_barrier_fill(bar, F, fs); } while (0)

    if (IN(0)) { for (int rep_ = 0; rep_ < (DUP_PHASE == 0 ? 2 : 1); ++rep_) p0_prologue(F); }
    if (IN(1)) { for (int rep_ = 0; rep_ < (DUP_PHASE == 1 ? 2 : 1); ++rep_) p1_prenorm(F); } SEAM(1);
    if (DUP_PHASE == 20) { for (int rep_ = 0; rep_ < 4; ++rep_) xcd_barrier(bar, F.wave); }
    if (IN(2)) {
        pg8::Gemm g{F.H, F.WIN, DM}; pg8::DenseOrder<TT, NPROJ_PAD, DM, 19, true> S; S.init(F.G, F.bid);
        pg8::EpiInproj E{F.PROJ, F.DT, F.dt_bias, F.QKV};
        for (int rep_ = 0; rep_ < (DUP_PHASE == 2 ? 2 : 1); ++rep_) pg8::gemm_phase<pg8::EpiInproj, pg8::DenseOrder<TT, NPROJ_PAD, DM, 19, true>, true>(F.lds, g, S, E, F.wave);
    } SEAM(2);
    if (IN(3)) {
        const bool conv_first = ((F.bid >> 3) & 1) != 0;
        if (conv_first) p3_conv(F);
        for (int rep_ = 0; rep_ < (DUP_PHASE == 3 ? 2 : 1); ++rep_) p3_attention(F);
        if (!conv_first) { for (int rep_ = 0; rep_ < (DUP_PHASE == 13 ? 2 : 1); ++rep_) p3_conv(F); }
    } SEAM(3);
    fs.mopen = 1;
    if (IN(4)) { for (int rep_ = 0; rep_ < (DUP_PHASE == 4 ? 2 : 1); ++rep_) p4_states(F); } SEAM(4);
    if (IN(5)) { for (int rep_ = 0; rep_ < (DUP_PHASE == 5 ? 2 : 1); ++rep_) p5_scan(F); } SEAM(5);
    if (IN(6)) { for (int rep_ = 0; rep_ < (DUP_PHASE == 6 ? 2 : 1); ++rep_) p6_ssd_out(F); }
    fill_drain(F, fs, 2, 0, LCTL);
    SEAM(6);
    if (IN(7)) {
        pg8::Gemm g{F.MIXIN, F.WOUT, 2048}; pg8::DenseOrder<TT, DM, 2048> S; S.init(F.G, F.bid);
        pg8::EpiBf16 E{F.MIX, DM, F.RR};
        for (int rep_ = 0; rep_ < (DUP_PHASE == 7 ? 2 : 1); ++rep_) pg8::gemm_phase<pg8::EpiBf16, pg8::DenseOrder<TT, DM, 2048>, true>(F.lds, g, S, E, F.wave);
    } SEAM(7);
    if (IN(8)) { p7_postmix(F); }
    __syncthreads();
    fill_drain(F, fs, 1, FQ_GU, LCTL);
    SEAM(8);
    if (IN(9) || IN(10)) {
        LAS int* tcum = (LAS int*)(F.lds + LDSCTL_OFF + 64); LAS int* cnt = (LAS int*)(F.lds + LDSCTL_OFF + 256); LAS int* texp = (LAS int*)(F.lds + LDSCTL_OFF + 512);
        const int vcu = (F.G % 8 == 0) ? (F.bid % 8) * (F.G / 8) + F.bid / 8 : F.bid;
        if (F.wave == 0) {
            const int l = lane_id_fresh(); int c = 0;
            if (l < NEXP) c = (int)__hip_atomic_load(F.ctl + CW_ECOUNT + l, __ATOMIC_RELAXED, __HIP_MEMORY_SCOPE_AGENT);
            const int tiles = (c + 255) >> 8; int incl = tiles;
#pragma unroll
            for (int o = 1; o < NEXP; o <<= 1) { const int y = __shfl_up(incl, o); if (l >= o) incl += y; }
            if (l < NEXP) { cnt[l] = c; tcum[l] = incl - tiles; }
            if (l == NEXP - 1) tcum[NEXP] = incl;
        }
        __syncthreads();
        { const int rt = F.wave * 64 + lane_id_fresh(); if (rt < 320) { int e = 0; for (int j = 1; j < NEXP; ++j) if (tcum[j] <= rt) e = j; texp[rt] = e; } }
        __syncthreads();
        if (IN(9)) {
            pg8::Gemm g{F.H, F.WGU, DM}; pg8::MoeOrder S{tcum, cnt, texp, F.SORT, 3, F.G, vcu, DM, (size_t)2048 * DM * 2, true, false};
            pg8::EpiSwiglu E{F.ACT, F.b_gu};
            for (int rep_ = 0; rep_ < (DUP_PHASE == 9 ? 2 : 1); ++rep_) pg8::gemm_phase<pg8::EpiSwiglu, pg8::MoeOrder, true>(F.lds, g, S, E, F.wave);
        }
        __syncthreads();
        fill_drain(F, fs, 1, FQ_ALL, LCTL);
        SEAM(9);
        if (IN(10)) {
            pg8::Gemm g{F.ACT, F.WDN, FF}; pg8::MoeOrder S{tcum, cnt, texp, F.SORT, 2, F.G, vcu, FF, (size_t)DM * FF * 2, false, true};
            pg8::EpiDown E{F.YSLOT, F.b_dn, F.SORT, F.SORTW, F.FLG};
            for (int rep_ = 0; rep_ < (DUP_PHASE == 10 ? 2 : 1); ++rep_) pg8::gemm_phase<pg8::EpiDown, pg8::MoeOrder, true>(F.lds, g, S, E, F.wave);
        }
    }
    SEAM(10);
    if (IN(11)) { for (int rep_ = 0; rep_ < (DUP_PHASE == 11 ? 2 : 1); ++rep_) p10_final(F); }
#undef IN
#undef SEAM
}

extern "C" void kernel_launch(void* const* d_in, const int* in_sizes, int n_in, void* d_out, int out_size, void* d_ws, size_t ws_size, hipStream_t stream) {
    static int grid = 0;
    if (grid == 0) {
        if (n_in != 22 || ws_size < WS_END) { fprintf(stderr, "kernel_launch: unexpected n_in %d / ws %zu\n", n_in, ws_size); grid = -1; return; }
        int dev = 0, cus = 0, per_cu = 0;
        if (hipGetDevice(&dev) != hipSuccess || hipDeviceGetAttribute(&cus, hipDeviceAttributeMultiprocessorCount, dev) != hipSuccess) { grid = -1; return; }
        if (hipFuncSetAttribute((const void*)mk_fwd, hipFuncAttributeMaxDynamicSharedMemorySize, LDS_BYTES) != hipSuccess) { fprintf(stderr, "kernel_launch: hipFuncSetAttribute failed\n"); grid = -1; return; }
        if (hipOccupancyMaxActiveBlocksPerMultiprocessor(&per_cu, (const void*)mk_fwd, NTHREADS, LDS_BYTES) != hipSuccess || per_cu < 1) fprintf(stderr, "kernel_launch: occupancy query says %d\n", per_cu);
        (void)hipGetLastError();
        grid = cus;
    }
    if (grid < 0) return;
    (void)hipMemsetAsync((char*)d_ws + WS_CTL, 0, CTL_BYTES, stream);
    Args a{};
    for (int i = 0; i < 22; ++i) a.in[i] = (const float*)d_in[i];
    a.out = (float*)d_out; a.ws = (unsigned char*)d_ws;
    for (int li = 0; li < MK_N_LAUNCHES; ++li) {
        if (MK_N_LAUNCHES == 1) { a.ph_lo = 0; a.ph_hi = N_PHASES; } else { a.ph_lo = li; a.ph_hi = li + 1; }
        hipLaunchKernelGGL(mk_fwd, dim3(grid), dim3(NTHREADS), LDS_BYTES, stream, a);
    }
}
```
